# Optimizing an MI355X kernel written in HIP

```python
import math
import jax, jax.numpy as jnp
from jax import lax
import numpy as np

D_MODEL = 4096
BATCH = 4
SEQ = 2048
DEPTH = 1
DEC_BATCH = 32
DEC_SEQ = 8
PAST_LEN = 8192
PAGE_SIZE = 128

MIX_WIDTH = D_MODEL
ATTN_WIDTH = MIX_WIDTH // 2
POOL_WIDTH = MIX_WIDTH - ATTN_WIDTH
HEAD_DIM = 128
N_HEADS = ATTN_WIDTH // HEAD_DIM
N_KV_HEADS = 4
KV_WIDTH = N_KV_HEADS * HEAD_DIM
IDX_HEADS = 32
IDX_DIM = 128
TOPK_MAX = 256
POOL_WINDOWS = (2, 4, 8, 16)
N_POOL_GROUPS = 4
POOL_GROUP = POOL_WIDTH // N_POOL_GROUPS
POOL_STATE = 15
N_BUCKETS = 32
MAX_DISTANCE = 128
RMS_EPS = 1e-6
Q_BLOCK = 128
SPLITS = (ATTN_WIDTH, KV_WIDTH, KV_WIDTH, ATTN_WIDTH, IDX_HEADS * IDX_DIM, IDX_HEADS, IDX_DIM, POOL_WIDTH, POOL_WIDTH)
IN_WIDTH = ATTN_WIDTH * 2 + KV_WIDTH * 2 + IDX_HEADS * IDX_DIM + IDX_HEADS + IDX_DIM + POOL_WIDTH * 2

kernel_name = "hybrid_dsa_pool_decoder_step"

F32 = jnp.float32


def rmsnorm(x, g):
    xf = x.astype(F32)
    var = jnp.mean(xf * xf, axis=-1, keepdims=True)
    return (xf * lax.rsqrt(var + RMS_EPS) * g.astype(F32)).astype(x.dtype)


def project(x, ln_g, w_in):
    B, T, _ = x.shape
    h = jnp.einsum('btd,dn->btn', rmsnorm(x, ln_g), w_in)
    parts = []
    off = 0
    for width in SPLITS:
        parts.append(h[..., off:off + width])
        off += width
    q, k, v, g_a, qi, wi, ki, u, g_b = parts
    q = q.reshape(B, T, N_HEADS, HEAD_DIM)
    k = k.reshape(B, T, N_KV_HEADS, HEAD_DIM)
    v = v.reshape(B, T, N_KV_HEADS, HEAD_DIM)
    qi = qi.reshape(B, T, IDX_HEADS, IDX_DIM) * (IDX_DIM ** -0.5)
    wi = wi * (IDX_HEADS ** -0.5)
    return q, k, v, g_a, qi, wi, ki, u, g_b


def t5_bucket(dist):
    max_exact = N_BUCKETS // 2
    d = jnp.maximum(dist, 0)
    df = jnp.maximum(d.astype(F32), 1.0)
    large = max_exact + (jnp.log(df / max_exact) / math.log(MAX_DISTANCE / max_exact)
                         * (N_BUCKETS - max_exact)).astype(jnp.int32)
    large = jnp.minimum(large, N_BUCKETS - 1)
    return jnp.where(d < max_exact, d, large)


def indexer_scores(qi, wi, ki):
    s = jnp.einsum('bthd,bsd->bths', qi, ki, preferred_element_type=F32)
    return jnp.einsum('bth,bths->bts', wi.astype(F32), jax.nn.relu(s))


def sparse_attend(q, k_sel, v_sel, sel_pos, q_pos, valid, rel_bias):
    B, T, H, D = q.shape
    K = sel_pos.shape[-1]
    R = H // N_KV_HEADS
    qg = q.reshape(B, T, N_KV_HEADS, R, D)
    logits = jnp.einsum('btgrd,btkgd->btgrk', qg, k_sel, preferred_element_type=F32) * (D ** -0.5)
    bucket = t5_bucket(q_pos[None, :, None] - sel_pos)
    bias = rel_bias[bucket].astype(F32).reshape(B, T, K, N_KV_HEADS, R)
    logits = logits + jnp.transpose(bias, (0, 1, 3, 4, 2))
    logits = jnp.where(valid[:, :, None, None, :], logits, -1e30)
    p = jax.nn.softmax(logits, axis=-1)
    o = jnp.einsum('btgrk,btkgd->btgrd', p.astype(v_sel.dtype), v_sel)
    return o.reshape(B, T, H * D)


def gather_rows(rows, idx):
    return jax.vmap(lambda r, i: r[i])(rows, idx)


def prompt_attention(q, k, v, qi, wi, ki, rel_bias):
    B, S = q.shape[:2]
    topk = min(TOPK_MAX, S // 4)
    n_blk = S // Q_BLOCK
    key_pos = jnp.arange(S)

    def block(i):
        t0 = i * Q_BLOCK
        qb = lax.dynamic_slice_in_dim(q, t0, Q_BLOCK, axis=1)
        qib = lax.dynamic_slice_in_dim(qi, t0, Q_BLOCK, axis=1)
        wib = lax.dynamic_slice_in_dim(wi, t0, Q_BLOCK, axis=1)
        q_pos = t0 + jnp.arange(Q_BLOCK)
        sc = indexer_scores(qib, wib, ki)
        sc = jnp.where((key_pos[None, :] <= q_pos[:, None])[None], sc, -jnp.inf)
        _, sel = lax.top_k(sc, topk)
        valid = sel <= q_pos[None, :, None]
        return sparse_attend(qb, gather_rows(k, sel), gather_rows(v, sel), sel, q_pos, valid, rel_bias)

    out = lax.map(block, jnp.arange(n_blk))
    return jnp.transpose(out, (1, 0, 2, 3)).reshape(B, S, ATTN_WIDTH)


def sample_attention(q, k_new, v_new, qi, wi, ki_new, cache_k, cache_v, cache_idx_k, page_table, rel_bias):
    Bd, T = q.shape[:2]
    n_pages = page_table.shape[1]
    past = n_pages * PAGE_SIZE
    L = past + T
    topk = min(TOPK_MAX, L // 4)
    past_ki = cache_idx_k[page_table].reshape(Bd, past, IDX_DIM)
    ki_all = jnp.concatenate([past_ki, ki_new.astype(past_ki.dtype)], axis=1)
    q_pos = past + jnp.arange(T)
    key_pos = jnp.arange(L)
    sc = indexer_scores(qi, wi, ki_all)
    sc = jnp.where((key_pos[None, :] <= q_pos[:, None])[None], sc, -jnp.inf)
    _, sel = lax.top_k(sc, topk)
    valid = sel <= q_pos[None, :, None]
    in_past = (sel < past)[..., None, None]
    ps = jnp.minimum(sel, past - 1)
    phys = gather_rows(page_table, ps // PAGE_SIZE)
    row = ps % PAGE_SIZE
    ns = jnp.clip(sel - past, 0, T - 1)
    k_sel = jnp.where(in_past, cache_k[phys, row], gather_rows(k_new, ns).astype(cache_k.dtype))
    v_sel = jnp.where(in_past, cache_v[phys, row], gather_rows(v_new, ns).astype(cache_v.dtype))
    return sparse_attend(q, k_sel, v_sel, sel, q_pos, valid, rel_bias)


def multiscale_pool(u_full, first_pos, n_ctx, w_pool, pool_scale):
    B, N, W = u_full.shape
    T = N - n_ctx
    uf = u_full.astype(F32)
    cs = jnp.concatenate([jnp.zeros((B, 1, W), F32), jnp.cumsum(uf, axis=1)], axis=1)
    j = n_ctx + jnp.arange(T)
    pos = first_pos + j
    outs = []
    for g, win in enumerate(POOL_WINDOWS):
        sl = slice(g * POOL_GROUP, (g + 1) * POOL_GROUP)
        lo = jnp.maximum(j + 1 - win, 0)
        cnt = jnp.minimum(pos + 1, win).astype(F32)
        mean = (cs[:, j + 1, sl] - cs[:, lo, sl]) / cnt[None, :, None]
        d = mean - uf[:, n_ctx:, sl]
        outs.append(jnp.einsum('btc,cd->btd', d, w_pool[g].astype(F32)))
    return (jnp.concatenate(outs, axis=-1) * pool_scale.astype(F32)).astype(u_full.dtype)


def merge(x, o_a, g_a, o_b, g_b, w_out):
    mix = jnp.concatenate([o_a * jax.nn.silu(g_a), o_b * jax.nn.silu(g_b)], axis=-1)
    return x + jnp.einsum('btm,md->btd', mix.astype(x.dtype), w_out)


def setup_inputs(seed: int = 0) -> dict:
    key = jax.random.key(seed)
    ks = jax.random.split(key, 16)
    n_pages = PAST_LEN // PAGE_SIZE
    n_used = DEC_BATCH * n_pages
    n_phys = n_used + (n_used + 3) // 4
    page_table = jax.random.permutation(ks[0], n_phys)[:n_used].reshape(DEC_BATCH, n_pages).astype(jnp.int32)
    nrm = jax.random.normal
    return {
        "x_prompt": nrm(ks[1], (BATCH, SEQ, D_MODEL), F32),
        "x_sample": nrm(ks[2], (DEC_BATCH, DEC_SEQ, D_MODEL), F32),
        "cache_k": nrm(ks[3], (DEPTH, n_phys, PAGE_SIZE, N_KV_HEADS, HEAD_DIM), F32),
        "cache_v": nrm(ks[4], (DEPTH, n_phys, PAGE_SIZE, N_KV_HEADS, HEAD_DIM), F32),
        "cache_idx_k": nrm(ks[5], (DEPTH, n_phys, PAGE_SIZE, IDX_DIM), F32),
        "state_pool": nrm(ks[6], (DEPTH, DEC_BATCH, POOL_STATE, POOL_WIDTH), F32),
        "page_table": page_table,
        "rel_bias": 0.5 * nrm(ks[7], (N_BUCKETS, N_HEADS), F32),
        "ln_g": 1.0 + 0.1 * nrm(ks[8], (DEPTH, D_MODEL), F32),
        "w_in": nrm(ks[9], (DEPTH, D_MODEL, IN_WIDTH), F32) * (D_MODEL ** -0.5),
        "w_pool": nrm(ks[10], (DEPTH, N_POOL_GROUPS, POOL_GROUP, POOL_GROUP), F32) * (POOL_GROUP ** -0.5),
        "pool_scale": 1.0 + 0.1 * nrm(ks[11], (DEPTH, POOL_WIDTH), F32),
        "w_out": nrm(ks[12], (DEPTH, MIX_WIDTH, D_MODEL), F32) * (MIX_WIDTH ** -0.5),
        "final_g": 1.0 + 0.1 * nrm(ks[13], (D_MODEL,), F32),
    }


def reference(x_prompt, x_sample, cache_k, cache_v, cache_idx_k, state_pool, page_table,
              rel_bias, ln_g, w_in, w_pool, pool_scale, w_out, final_g):
    past = page_table.shape[1] * PAGE_SIZE
    hp, hs = x_prompt, x_sample
    kp, vp, ikp, pp = [], [], [], []
    ksm, vsm, iks, psm = [], [], [], []
    for layer in range(DEPTH):
        q, k, v, g_a, qi, wi, ki, u, g_b = project(hp, ln_g[layer], w_in[layer])
        o_a = prompt_attention(q, k, v, qi, wi, ki, rel_bias)
        o_b = multiscale_pool(u, 0, 0, w_pool[layer], pool_scale[layer])
        hp = merge(hp, o_a, g_a, o_b, g_b, w_out[layer])
        kp.append(k)
        vp.append(v)
        ikp.append(ki)
        pp.append(u[:, -POOL_STATE:])
        q, k, v, g_a, qi, wi, ki, u, g_b = project(hs, ln_g[layer], w_in[layer])
        o_a = sample_attention(q, k, v, qi, wi, ki, cache_k[layer], cache_v[layer],
                               cache_idx_k[layer], page_table, rel_bias)
        u_full = jnp.concatenate([state_pool[layer].astype(u.dtype), u], axis=1)
        o_b = multiscale_pool(u_full, past - POOL_STATE, POOL_STATE, w_pool[layer], pool_scale[layer])
        hs = merge(hs, o_a, g_a, o_b, g_b, w_out[layer])
        ksm.append(k)
        vsm.append(v)
        iks.append(ki)
        psm.append(u_full[:, -POOL_STATE:])
    y_prompt = rmsnorm(hp, final_g)
    y_sample = rmsnorm(hs, final_g)
    return (y_prompt, y_sample, jnp.stack(kp), jnp.stack(vp), jnp.stack(ikp), jnp.stack(pp),
            jnp.stack(ksm), jnp.stack(vsm), jnp.stack(iks), jnp.stack(psm))
```

```cpp
#include <hip/hip_runtime.h>
#include <cstdio>
#include <cstdint>

#ifndef MK_N_LAUNCHES
#define MK_N_LAUNCHES 1
#endif

#define LAS __attribute__((address_space(3)))
#define GAS __attribute__((address_space(1)))
typedef _Float16 f16;
typedef _Float16 f16x8 __attribute__((ext_vector_type(8)));
typedef _Float16 f16x4 __attribute__((ext_vector_type(4)));
typedef _Float16 f16x2 __attribute__((ext_vector_type(2)));
typedef float f32x4 __attribute__((ext_vector_type(4)));
typedef float f32x2 __attribute__((ext_vector_type(2)));
typedef unsigned u32x4 __attribute__((ext_vector_type(4)));
typedef unsigned u32x2 __attribute__((ext_vector_type(2)));

constexpr int DM = 4096, NB = 4, SEQ = 2048, DB = 32, DS = 8, PAST = 8192, PAGE = 128, NPAGES = 64;
constexpr int NPROMPT = NB * SEQ, NSAMP = DB * DS, NT = NPROMPT + NSAMP;
constexpr int ATTW = 2048, KVW = 512, HD = 128, NH = 16, NKV = 4, IH = 32, IDIM = 128, TOPK = 256, PW = 2048, PGRP = 512, PSTATE = 15;
constexpr int INW = 13472, INWP = 13568;
constexpr float RMS_EPS = 1e-6f;
constexpr size_t OFF_YP = 0, OFF_YS = 33554432, OFF_KP = 34603008, OFF_VP = 38797312, OFF_IKP = 42991616, OFF_PSP = 44040192,
                 OFF_KS = 44163072, OFF_VS = 44294144, OFF_IKS = 44425216, OFF_PSS = 44457984, OUT_TOTAL = 45441024;
constexpr size_t MiB = 1u << 20;
constexpr size_t WS_CTL = 0, CTL_ZERO_BYTES = 1 * MiB;
constexpr size_t WS_WTIN = 2 * MiB;
constexpr size_t WS_WTOUT = 110 * MiB;
constexpr size_t WS_WTPOOL = 142 * MiB;
constexpr size_t WS_XN = 144 * MiB;
constexpr size_t WS_Q = 210 * MiB;
constexpr size_t WS_KH = 243 * MiB;
constexpr size_t WS_VH = 252 * MiB;
constexpr size_t WS_GA = 261 * MiB;
constexpr size_t WS_QI = 294 * MiB;
constexpr size_t WS_WI = 360 * MiB;
constexpr size_t WS_KI = 362 * MiB;
constexpr size_t WS_U = 365 * MiB;
constexpr size_t WS_GB = 431 * MiB;
constexpr size_t WS_D = 464 * MiB;
constexpr size_t WS_MIX = 497 * MiB;
constexpr size_t WS_H = 563 * MiB;
constexpr size_t WS_SEL = 695 * MiB;
constexpr size_t WS_END = 704 * MiB;
constexpr int CW_BAR = 4096;

namespace pg8 {
constexpr int BM = 256, BK = 64, HALF = 128, HTB = HALF * BK * 2, STAGE_BYTES = 8 * HTB, NXCD = 8, WGM = 8;
__host__ __device__ __forceinline__ int lds_byte(int r, int c) { const int st = (r >> 4) * 2 + (c >> 5), rr = r & 15, cc = c & 31, ob = rr * 64 + cc * 2; return st * 1024 + (ob ^ (((ob >> 9) & 1) << 5)); }
__host__ __device__ __forceinline__ void stage_rc(int b, int& R, int& C) { const int st = b / 1024, sb = b % 1024, swz = sb ^ (((sb >> 9) & 1) << 5); R = (st >> 1) * 16 + swz / 64; C = (st & 1) * 32 + (swz % 64) / 2; }
__host__ __device__ __forceinline__ int perm32(int rho) { const int n = rho >> 4, i = rho & 15; return 8 * (i >> 2) + 4 * n + (i & 3); }
struct Unit { int pm, pn; };
struct Gemm { const f16* A; const f16* Bt; int M, N, K, lda, ldb; int a_grp_shift; int a_grp_cols; };
struct StaticOrder {
    int nM, nN, nwg, G, c;
    __host__ __device__ void init(int M, int N, int G_, int c_) { nM = M / BM; nN = N / BM; nwg = nM * nN; G = G_; c = c_; }
    __host__ __device__ bool next(int i, Unit& u) const {
        const long L = (long)i * G + c; if (L >= nwg) return false;
        int wgid = (int)L; { const int q = nwg / NXCD, r = nwg % NXCD, xcd = wgid % NXCD, off = wgid / NXCD; wgid = (xcd < r ? xcd * (q + 1) : r * (q + 1) + (xcd - r) * q) + off; }
        const int nig = WGM * nN, gid = wgid / nig, fm = gid * WGM, gsz = (nM - fm) < WGM ? (nM - fm) : WGM;
        u.pm = fm + ((wgid % nig) % gsz); u.pn = (wgid % nig) / gsz; return true;
    }
};
template <class Epi, bool ALIGN_EPI = true, bool SP2 = true>
__device__ __forceinline__ void gemm_phase(LAS unsigned char* lds, const Gemm g, const StaticOrder& S, const Epi& E) {
    const int tid = threadIdx.x, wid = __builtin_amdgcn_readfirstlane(tid >> 6), lane = tid & 63, wr = wid >> 2, wc = wid & 3, fr = lane & 15, fq = lane >> 4;
    const int K = g.K, nt = K / BK;
    unsigned voffA[2], voffB[2];
#pragma unroll
    for (int i = 0; i < 2; ++i) { int R, C; stage_rc(tid * 16 + i * 8192, R, C); const int Rb = (R & ~31) + perm32(R & 31);
        voffA[i] = (unsigned)(R * g.lda + C) * 2u; voffB[i] = (unsigned)(Rb * g.ldb + C) * 2u; }
    const size_t kstep = (size_t)(BK * 2);
    const size_t hstepA = (size_t)HALF * g.lda * 2, hstepB = (size_t)HALF * g.ldb * 2;
    const size_t tstepA = 2 * hstepA, tstepB = 2 * hstepB;
    const unsigned ldsw = (unsigned)wid * 1024u;
    const int aoff = lds_byte(wr * 64 + fr, fq * 8), boff = lds_byte(wc * 32 + fr, fq * 8);
#define PG8_SA(b, h) (((b) * 2 + (h)) * HTB)
#define PG8_SB(b, h) ((4 + (b) * 2 + (h)) * HTB)
#define PG8_STAGE(bufoff, gbase, voff) do { _Pragma("unroll") for (int _i = 0; _i < 2; ++_i) \
        __builtin_amdgcn_global_load_lds((const unsigned*)((const char*)(gbase) + (voff)[_i]), (LAS unsigned*)(lds + (bufoff) + ldsw + _i * 8192), 16, 0, 0); } while (0)
#define PG8_LDA(dst, b, h) do { _Pragma("unroll") for (int m = 0; m < 4; ++m) _Pragma("unroll") for (int k = 0; k < 2; ++k) dst[m][k] = *(const LAS f16x8*)(lds + PG8_SA(b, h) + aoff + m * 2048 + k * 1024); } while (0)
#define PG8_LDB(dst, b, h) do { _Pragma("unroll") for (int n = 0; n < 2; ++n) _Pragma("unroll") for (int k = 0; k < 2; ++k) dst[n][k] = *(const LAS f16x8*)(lds + PG8_SB(b, h) + boff + n * 2048 + k * 1024); } while (0)
#define PG8_MMA(ai, bj, At, Bt) do { __builtin_amdgcn_s_setprio(1); _Pragma("unroll") for (int m = 0; m < 4; ++m) _Pragma("unroll") for (int n = 0; n < 2; ++n) _Pragma("unroll") for (int k = 0; k < 2; ++k) \
        acc[ai][bj][m][n] = __builtin_amdgcn_mfma_f32_16x16x32_f16(Bt[n][k], At[m][k], acc[ai][bj][m][n], 0, 0, 0); __builtin_amdgcn_s_setprio(0); } while (0)
#define PG8_WAIT_V(n) asm volatile("s_waitcnt vmcnt(" #n ")" ::: "memory")
#define PG8_WAIT_L(n) asm volatile("s_waitcnt lgkmcnt(" #n ")" ::: "memory")
#define PG8_BAR __builtin_amdgcn_s_barrier()
#define PG8_SCHED __builtin_amdgcn_sched_barrier(0)
#define PG8_AOFF(u) ((size_t)(u).pm * tstepA + (g.a_grp_cols ? (size_t)(((u).pn >> g.a_grp_shift) * g.a_grp_cols) * 2 : (size_t)0))
    Unit cur, nxt; int ui = 0;
    if (!S.next(0, cur)) return;
    f32x4 acc[2][2][4][2];
#pragma unroll
    for (int a = 0; a < 2; ++a)
#pragma unroll
        for (int b = 0; b < 2; ++b)
#pragma unroll
            for (int m = 0; m < 4; ++m)
#pragma unroll
                for (int n = 0; n < 2; ++n) acc[a][b][m][n] = (f32x4){0.f, 0.f, 0.f, 0.f};
    f16x8 At[4][2], B0[2][2], B1[2][2];
    const char* cA = (const char*)g.A + PG8_AOFF(cur); const char* cB = (const char*)g.Bt + (size_t)cur.pn * tstepB;
    if constexpr (SP2) {
        PG8_STAGE(PG8_SB(0, 0), cB, voffB); PG8_STAGE(PG8_SB(0, 1), cB + hstepB, voffB); PG8_STAGE(PG8_SA(0, 0), cA, voffA); PG8_STAGE(PG8_SA(0, 1), cA + hstepA, voffA);
        if (wr == 1) PG8_BAR;
        PG8_WAIT_V(2); PG8_BAR;
        PG8_STAGE(PG8_SB(1, 0), cB + kstep, voffB); PG8_STAGE(PG8_SA(1, 0), cA + kstep, voffA); PG8_STAGE(PG8_SB(1, 1), cB + hstepB + kstep, voffB);
        PG8_WAIT_V(6); PG8_BAR;
    } else {
        PG8_STAGE(PG8_SB(0, 0), cB, voffB); PG8_STAGE(PG8_SA(0, 0), cA, voffA); PG8_STAGE(PG8_SB(0, 1), cB + hstepB, voffB); PG8_STAGE(PG8_SA(0, 1), cA + hstepA, voffA);
        if (wr == 1) PG8_BAR;
        PG8_WAIT_V(4); PG8_BAR;
        PG8_STAGE(PG8_SB(1, 0), cB + kstep, voffB); PG8_STAGE(PG8_SA(1, 0), cA + kstep, voffA); PG8_STAGE(PG8_SB(1, 1), cB + hstepB + kstep, voffB);
        PG8_WAIT_V(6); PG8_BAR;
    }
    for (;;) {
        const bool has_next = S.next(ui + 1, nxt);
        const char* nA = has_next ? (const char*)g.A + PG8_AOFF(nxt) : cA; const char* nB = has_next ? (const char*)g.Bt + (size_t)nxt.pn * tstepB : cB;
        for (int t = 0; t < nt; t += 2) {
            const bool last = (t == nt - 2);
            const char* a1 = cA + (size_t)(t + 1) * kstep;
            const char* a2 = last ? nA : cA + (size_t)(t + 2) * kstep; const char* b2 = last ? nB : cB + (size_t)(t + 2) * kstep;
            const char* a3 = a2 + kstep; const char* b3 = b2 + kstep;
            if constexpr (SP2) {
            PG8_LDB(B0, 0, 0); PG8_LDB(B1, 0, 1); PG8_SCHED; PG8_LDA(At, 0, 0); PG8_STAGE(PG8_SA(1, 1), a1 + hstepA, voffA);
            PG8_WAIT_V(8); PG8_WAIT_L(0); PG8_BAR; PG8_MMA(0, 0, At, B0); PG8_MMA(0, 1, At, B1); PG8_BAR; PG8_SCHED;
            PG8_LDA(At, 0, 1); PG8_STAGE(PG8_SB(0, 0), b2, voffB); PG8_STAGE(PG8_SB(0, 1), b2 + hstepB, voffB); PG8_STAGE(PG8_SA(0, 0), a2, voffA);
            PG8_WAIT_V(8); PG8_WAIT_L(0); PG8_BAR; PG8_MMA(1, 0, At, B0); PG8_MMA(1, 1, At, B1); PG8_BAR; PG8_SCHED;
            PG8_LDB(B0, 1, 0); PG8_LDB(B1, 1, 1); PG8_SCHED; PG8_LDA(At, 1, 0); PG8_STAGE(PG8_SA(0, 1), a2 + hstepA, voffA);
            PG8_WAIT_V(8); PG8_WAIT_L(0); PG8_BAR; PG8_MMA(0, 0, At, B0); PG8_MMA(0, 1, At, B1); PG8_BAR; PG8_SCHED;
            PG8_LDA(At, 1, 1); PG8_STAGE(PG8_SB(1, 0), b3, voffB); PG8_STAGE(PG8_SB(1, 1), b3 + hstepB, voffB); PG8_STAGE(PG8_SA(1, 0), a3, voffA);
            PG8_WAIT_V(8); PG8_WAIT_L(0); PG8_BAR; PG8_MMA(1, 0, At, B0); PG8_MMA(1, 1, At, B1); PG8_BAR; PG8_SCHED;
            } else {
            PG8_LDB(B0, 0, 0); PG8_SCHED; PG8_LDA(At, 0, 0); PG8_STAGE(PG8_SA(1, 1), a1 + hstepA, voffA);
            PG8_WAIT_L(8); PG8_BAR; PG8_WAIT_L(0); PG8_MMA(0, 0, At, B0); PG8_BAR; PG8_SCHED;
            PG8_LDB(B1, 0, 1); PG8_STAGE(PG8_SB(0, 0), b2, voffB);
            PG8_BAR; PG8_WAIT_L(0); PG8_MMA(0, 1, At, B1); PG8_BAR;
            PG8_LDA(At, 0, 1); PG8_STAGE(PG8_SA(0, 0), a2, voffA);
            PG8_BAR; PG8_WAIT_L(0); PG8_MMA(1, 0, At, B0); PG8_BAR; PG8_SCHED;
            PG8_STAGE(PG8_SB(0, 1), b2 + hstepB, voffB);
            PG8_WAIT_V(6); PG8_BAR; PG8_MMA(1, 1, At, B1); PG8_BAR;
            PG8_LDB(B0, 1, 0); PG8_SCHED; PG8_LDA(At, 1, 0); PG8_STAGE(PG8_SA(0, 1), a2 + hstepA, voffA);
            PG8_WAIT_L(8); PG8_BAR; PG8_WAIT_L(0); PG8_MMA(0, 0, At, B0); PG8_BAR; PG8_SCHED;
            PG8_LDB(B1, 1, 1); PG8_STAGE(PG8_SB(1, 0), b3, voffB);
            PG8_BAR; PG8_WAIT_L(0); PG8_MMA(0, 1, At, B1); PG8_BAR;
            PG8_LDA(At, 1, 1); PG8_STAGE(PG8_SA(1, 0), a3, voffA);
            PG8_BAR; PG8_WAIT_L(0); PG8_MMA(1, 0, At, B0); PG8_BAR; PG8_SCHED;
            PG8_STAGE(PG8_SB(1, 1), b3 + hstepB, voffB);
            PG8_WAIT_V(6); PG8_BAR; PG8_MMA(1, 1, At, B1); PG8_BAR;
            }
        }
        if constexpr (ALIGN_EPI) { if (wr == 0) PG8_BAR; }
        E(acc, cur, wr, wc, fr, fq);
        if (!has_next) break;
#pragma unroll
        for (int a = 0; a < 2; ++a)
#pragma unroll
            for (int b = 0; b < 2; ++b)
#pragma unroll
                for (int m = 0; m < 4; ++m)
#pragma unroll
                    for (int n = 0; n < 2; ++n) acc[a][b][m][n] = (f32x4){0.f, 0.f, 0.f, 0.f};
        cur = nxt; cA = nA; cB = nB; ++ui;
        if constexpr (ALIGN_EPI) { if (wr == 1) PG8_BAR; }
    }
    PG8_WAIT_V(0);
    if constexpr (!ALIGN_EPI) { if (wr == 0) PG8_BAR; }
    PG8_BAR;
#undef PG8_SA
#undef PG8_SB
#undef PG8_STAGE
#undef PG8_LDA
#undef PG8_LDB
#undef PG8_MMA
#undef PG8_WAIT_V
#undef PG8_WAIT_L
#undef PG8_BAR
#undef PG8_SCHED
#undef PG8_AOFF
}
}

constexpr int RING_OFF = 0, RING_BYTES = 131072;
constexpr int LDSCTL_OFF = RING_BYTES, MISC_OFF = LDSCTL_OFF + 320;
constexpr int LDS_BYTES = 147456;
constexpr int NWAVES = 8;

#define LDS_WAIT() asm volatile("s_waitcnt lgkmcnt(0)" ::: "memory")
#define VM_WAIT() asm volatile("s_waitcnt vmcnt(0)" ::: "memory")
__device__ __forceinline__ unsigned pkh(float lo, float hi) { f16x2 v; v.x = (f16)lo; v.y = (f16)hi; return __builtin_bit_cast(unsigned, v); }
__device__ __forceinline__ f16x2 as_h2(unsigned u) { return __builtin_bit_cast(f16x2, u); }
__device__ __forceinline__ float silu_f(float x) { return x * __builtin_amdgcn_rcpf(1.0f + __expf(-x)); }

#define XB_TMO      128
#define XB_XCNT(j)  (256  + 64 * (j))
#define XB_XSUB(j)  (1280 + 64 * (j))
#define XB_XGEN(j)  (2304 + 64 * (j))
#define XB_TOP      3328
#define XB_TOPGEN   3392
#define XCD_BAR_WORDS 3456
#define XB_SPIN_CAP (1u << 18)
__device__ __forceinline__ unsigned xb_ld(unsigned* p)              { return __hip_atomic_load(p, __ATOMIC_RELAXED, __HIP_MEMORY_SCOPE_AGENT); }
__device__ __forceinline__ unsigned xb_add(unsigned* p, unsigned v) { return __hip_atomic_fetch_add(p, v, __ATOMIC_RELAXED, __HIP_MEMORY_SCOPE_AGENT); }
__device__ __forceinline__ unsigned xb_xcc_id() { return (unsigned)__builtin_amdgcn_s_getreg((3 << 11) | 20) & 0xFu; }
#define XB_SPIN(cond, bar) do { unsigned _sp = 0; while (cond) { __builtin_amdgcn_s_sleep(1); \
    if ((++_sp & 255u) == 0u) { if (xb_ld(&(bar)[XB_TMO])) break; if (_sp > XB_SPIN_CAP) { atomicAdd(&(bar)[XB_TMO], 1u); break; } } } } while (0)
struct XcdBarrier { unsigned* bar; unsigned x; volatile LAS unsigned* st; };
__device__ __forceinline__ XcdBarrier xcd_barrier_post(unsigned* bar, volatile LAS unsigned* st) {
    XcdBarrier b; b.bar = bar; b.x = xb_xcc_id(); b.st = st;
    if (threadIdx.x == 0) (void)xb_add(&bar[XB_XCNT(b.x)], 1u);
    return b;
}
__device__ __forceinline__ void xcd_barrier_complete(unsigned* bar, unsigned x, unsigned& nloc, unsigned& nx) {
    const unsigned G = gridDim.x * gridDim.y * gridDim.z;
    unsigned sum, cnt, mine, sp = 0u;
    for (;;) {
        sum = 0u; cnt = 0u; mine = 0u;
#pragma unroll
        for (unsigned j = 0; j < 16; ++j) { const unsigned c = xb_ld(&bar[XB_XCNT(j)]); sum += c; cnt += (c > 0u) ? 1u : 0u; mine = (j == x) ? c : mine; }
        if (sum == G) break;
        __builtin_amdgcn_s_sleep(1);
        if ((++sp & 255u) == 0u) { if (xb_ld(&bar[XB_TMO])) break; if (sp > XB_SPIN_CAP) { atomicAdd(&bar[XB_TMO], 1u); break; } }
    }
    nloc = mine > 0u ? mine : 1u; nx = cnt > 0u ? cnt : 1u;
}
__device__ __forceinline__ void xcd_barrier(const XcdBarrier& b) {
    asm volatile("s_waitcnt vmcnt(0)" ::: "memory");
    __syncthreads();
    if (threadIdx.x == 0) {
        unsigned* bar = b.bar;
        __builtin_amdgcn_s_waitcnt(0);
        unsigned nloc = b.st[0], nx = b.st[1];
        if (nloc == 0u) { xcd_barrier_complete(bar, b.x, nloc, nx); b.st[0] = nloc; b.st[1] = nx; }
        const unsigned old = xb_add(&bar[XB_XSUB(b.x)], 1u);
        const unsigned gen = old / nloc;
        if (old + 1u == (gen + 1u) * nloc) {
            __builtin_amdgcn_fence(__ATOMIC_RELEASE, "agent");
            asm volatile("s_waitcnt vmcnt(0)" ::: "memory");
            const unsigned og = xb_add(&bar[XB_TOP], 1u);
            const unsigned tg = og / nx;
            if (og + 1u == (tg + 1u) * nx) xb_add(&bar[XB_TOPGEN], 1u);
            else XB_SPIN(xb_ld(&bar[XB_TOPGEN]) == tg, bar);
            __builtin_amdgcn_fence(__ATOMIC_ACQUIRE, "agent");
            xb_add(&bar[XB_XGEN(b.x)], 1u);
            asm volatile("s_waitcnt vmcnt(0)" ::: "memory");
        } else {
            XB_SPIN(xb_ld(&bar[XB_XGEN(b.x)]) == gen, bar);
            __builtin_amdgcn_fence(__ATOMIC_ACQUIRE, "agent");
            asm volatile("s_waitcnt vmcnt(0)" ::: "memory");
        }
    }
    __syncthreads();
}

struct Frame {
    LAS unsigned char* lds;
    int tid, lane, wave, vcu, G;
    const float *x_prompt, *x_sample, *cache_k, *cache_v, *cache_ik, *state_pool; const int* page_table;
    const float *rel_bias, *ln_g, *w_in, *w_pool, *pool_scale, *w_out, *final_g;
    float* out; unsigned char* ws;
};
__device__ __forceinline__ const float* x_row(const Frame& F, int r) { return r < NPROMPT ? F.x_prompt + (size_t)r * DM : F.x_sample + (size_t)(r - NPROMPT) * DM; }
__device__ __forceinline__ float wave_sum(float v) {
#pragma unroll
    for (int o = 1; o < 64; o <<= 1) v += __shfl_xor(v, o);
    return v;
}
__device__ __forceinline__ float wave_max(float v) {
#pragma unroll
    for (int o = 1; o < 64; o <<= 1) v = fmaxf(v, __shfl_xor(v, o));
    return v;
}

__device__ __forceinline__ void p0_transpose_item(const float* W, int K, int N, int src_n0, f16* WT, int dst_row0, int k0, LAS float* scr, int lane) {
#pragma unroll 8
    for (int i = 0; i < 32; ++i) { const int kk = 2 * i + (lane >> 5); scr[kk * 33 + (lane & 31)] = src_n0 >= 0 ? W[(size_t)(k0 + kk) * N + src_n0 + (lane & 31)] : 0.f; }
    LDS_WAIT(); asm volatile("" ::: "memory");
    const int c = lane & 7;
#pragma unroll
    for (int j = 0; j < 4; ++j) { const int n = (lane >> 3) + 8 * j; const LAS float* s = scr + (8 * c) * 33 + n;
        u32x4 o; o.x = pkh(s[0 * 33], s[1 * 33]); o.y = pkh(s[2 * 33], s[3 * 33]); o.z = pkh(s[4 * 33], s[5 * 33]); o.w = pkh(s[6 * 33], s[7 * 33]);
        *(GAS u32x4*)(WT + (size_t)(dst_row0 + n) * K + k0 + 8 * c) = o; }
    LDS_WAIT(); asm volatile("" ::: "memory");
}
__device__ __forceinline__ void p0_prologue(Frame& F) {
    LAS float* scr = (LAS float*)(F.lds + RING_OFF + F.wave * 16384);
    const int gw = F.vcu * NWAVES + F.wave, NGW = F.G * NWAVES;
    constexpr int NBI = INWP / 32;
    constexpr int I_IN = 64 * NBI, I_OUT = 64 * 128, I_POOL = 4 * 8 * 16;
    f16* wtin = (f16*)(F.ws + WS_WTIN); f16* wtout = (f16*)(F.ws + WS_WTOUT); f16* wtpool = (f16*)(F.ws + WS_WTPOOL);
    for (int it = gw; it < I_IN + I_OUT + I_POOL; it += NGW) {
        int r = it;
        if (r < I_IN) { const int kb = r / NBI, nb = r % NBI; const int n0 = 32 * nb;
            const int src = n0 < 9376 ? n0 : (n0 < 9472 ? -1 : n0 - 96);
            p0_transpose_item(F.w_in, DM, INW, src, wtin, n0, 64 * kb, scr, F.lane); continue; }
        r -= I_IN;
        if (r < I_OUT) { const int kb = r / 128, nb = r % 128; p0_transpose_item(F.w_out, DM, DM, 32 * nb, wtout, 32 * nb, 64 * kb, scr, F.lane); continue; }
        r -= I_OUT;
        { const int g = r / 128, q = r % 128, kb = q / 16, nb = q % 16;
          p0_transpose_item(F.w_pool + (size_t)g * PGRP * PGRP, PGRP, PGRP, 32 * nb, wtpool + (size_t)g * PGRP * PGRP, 32 * nb, 64 * kb, scr, F.lane); }
    }
    f16* xn = (f16*)(F.ws + WS_XN);
    for (int m = gw; m < NT; m += NGW) {
        const GAS f32x4* xr = (const GAS f32x4*)x_row(F, m) + F.lane;
        f32x4 v[16]; float s = 0.f;
#pragma unroll
        for (int j = 0; j < 16; ++j) { v[j] = xr[64 * j]; s += (v[j].x * v[j].x + v[j].y * v[j].y) + (v[j].z * v[j].z + v[j].w * v[j].w); }
        const float rstd = 1.0f / sqrtf(wave_sum(s) * (1.f / DM) + RMS_EPS);
        GAS u32x2* o8 = (GAS u32x2*)(xn + (size_t)m * DM) + F.lane;
        const GAS f32x4* gr = (const GAS f32x4*)F.ln_g + F.lane;
#pragma unroll
        for (int j = 0; j < 16; ++j) { const f32x4 gg = gr[64 * j]; u32x2 w; w.x = pkh(v[j].x * rstd * gg.x, v[j].y * rstd * gg.y); w.y = pkh(v[j].z * rstd * gg.z, v[j].w * rstd * gg.w); o8[64 * j] = w; }
    }
}

struct Epi1 {
    float* out; unsigned char* ws;
    __device__ __forceinline__ void operator()(const f32x4 (&acc)[2][2][4][2], const pg8::Unit& u, int wr, int wc, int fr, int fq) const {
        const int pn = u.pn; const int row0 = u.pm * 256 + wr * 64 + fr; const int cc0 = wc * 32 + 8 * fq;
#pragma unroll
        for (int ai = 0; ai < 2; ++ai)
#pragma unroll
            for (int m = 0; m < 4; ++m) {
                const int row = row0 + ai * 128 + m * 16;
#pragma unroll
                for (int bj = 0; bj < 2; ++bj) {
                    const int cc = cc0 + bj * 128; f32x4 v0 = acc[ai][bj][m][0], v1 = acc[ai][bj][m][1];
                    if (pn < 8) {
                        const float s = 0.08838834764831845f; u32x4 w; w.x = pkh(v0.x * s, v0.y * s); w.y = pkh(v0.z * s, v0.w * s); w.z = pkh(v1.x * s, v1.y * s); w.w = pkh(v1.z * s, v1.w * s);
                        *(GAS u32x4*)((f16*)(ws + WS_Q) + (size_t)row * ATTW + pn * 256 + cc) = w;
                    } else if (pn < 12) {
                        const bool isv = pn >= 10; const int col = (pn - (isv ? 10 : 8)) * 256 + cc;
                        float* o = out + (row < NPROMPT ? (isv ? OFF_VP : OFF_KP) + (size_t)row * KVW : (isv ? OFF_VS : OFF_KS) + (size_t)(row - NPROMPT) * KVW) + col;
                        *(GAS f32x4*)o = v0; *(GAS f32x4*)(o + 4) = v1;
                        u32x4 w; w.x = pkh(v0.x, v0.y); w.y = pkh(v0.z, v0.w); w.z = pkh(v1.x, v1.y); w.w = pkh(v1.z, v1.w);
                        *(GAS u32x4*)((f16*)(ws + (isv ? WS_VH : WS_KH)) + (size_t)row * KVW + col) = w;
                    } else if (pn < 20 || pn >= 45) {
                        const bool isb = pn >= 45; const int col = (pn - (isb ? 45 : 12)) * 256 + cc;
                        u32x4 w; w.x = pkh(silu_f(v0.x), silu_f(v0.y)); w.y = pkh(silu_f(v0.z), silu_f(v0.w)); w.z = pkh(silu_f(v1.x), silu_f(v1.y)); w.w = pkh(silu_f(v1.z), silu_f(v1.w));
                        *(GAS u32x4*)((f16*)(ws + (isb ? WS_GB : WS_GA)) + (size_t)row * 2048 + col) = w;
                    } else if (pn < 36) {
                        const float s = 0.08838834764831845f; u32x4 w; w.x = pkh(v0.x * s, v0.y * s); w.y = pkh(v0.z * s, v0.w * s); w.z = pkh(v1.x * s, v1.y * s); w.w = pkh(v1.z * s, v1.w * s);
                        *(GAS u32x4*)((f16*)(ws + WS_QI) + (size_t)row * 4096 + (pn - 20) * 256 + cc) = w;
                    } else if (pn == 36) {
                        if (cc < 32) { const float s = 0.17677669529663687f; float* o = (float*)(ws + WS_WI) + (size_t)row * 32 + cc; *(GAS f32x4*)o = v0 * s; *(GAS f32x4*)(o + 4) = v1 * s; }
                        else if (cc < 160) { const int col = cc - 32;
                            float* o = out + (row < NPROMPT ? OFF_IKP + (size_t)row * IDIM : OFF_IKS + (size_t)(row - NPROMPT) * IDIM) + col;
                            *(GAS f32x4*)o = v0; *(GAS f32x4*)(o + 4) = v1;
                            u32x4 w; w.x = pkh(v0.x, v0.y); w.y = pkh(v0.z, v0.w); w.z = pkh(v1.x, v1.y); w.w = pkh(v1.z, v1.w);
                            *(GAS u32x4*)((f16*)(ws + WS_KI) + (size_t)row * IDIM + col) = w; }
                    } else {
                        float* o = (float*)(ws + WS_U) + (size_t)row * PW + (pn - 37) * 256 + cc; *(GAS f32x4*)o = v0; *(GAS f32x4*)(o + 4) = v1;
                    }
                }
            }
    }
};
struct EpiPool {
    const float* pool_scale; unsigned char* ws;
    __device__ __forceinline__ void operator()(const f32x4 (&acc)[2][2][4][2], const pg8::Unit& u, int wr, int wc, int fr, int fq) const {
        const int row0 = u.pm * 256 + wr * 64 + fr, col0 = u.pn * 256 + wc * 32 + 8 * fq;
#pragma unroll
        for (int bj = 0; bj < 2; ++bj) {
            const int col = col0 + bj * 128; const f32x4 s0 = *(const GAS f32x4*)(pool_scale + col), s1 = *(const GAS f32x4*)(pool_scale + col + 4);
#pragma unroll
            for (int ai = 0; ai < 2; ++ai)
#pragma unroll
                for (int m = 0; m < 4; ++m) { const int row = row0 + ai * 128 + m * 16;
                    const f16x8 gb = *(const GAS f16x8*)((const f16*)(ws + WS_GB) + (size_t)row * PW + col);
                    const f32x4 v0 = acc[ai][bj][m][0] * s0, v1 = acc[ai][bj][m][1] * s1;
                    u32x4 w; w.x = pkh(v0.x * (float)gb[0], v0.y * (float)gb[1]); w.y = pkh(v0.z * (float)gb[2], v0.w * (float)gb[3]);
                    w.z = pkh(v1.x * (float)gb[4], v1.y * (float)gb[5]); w.w = pkh(v1.z * (float)gb[6], v1.w * (float)gb[7]);
                    *(GAS u32x4*)((f16*)(ws + WS_MIX) + (size_t)row * DM + ATTW + col) = w; }
        }
    }
};
struct Epi2 {
    const float* x_prompt; const float* x_sample; unsigned char* ws;
    __device__ __forceinline__ void operator()(const f32x4 (&acc)[2][2][4][2], const pg8::Unit& u, int wr, int wc, int fr, int fq) const {
        const int row0 = u.pm * 256 + wr * 64 + fr, col0 = u.pn * 256 + wc * 32 + 8 * fq;
#pragma unroll
        for (int ai = 0; ai < 2; ++ai)
#pragma unroll
            for (int m = 0; m < 4; ++m) { const int row = row0 + ai * 128 + m * 16;
                const float* xr = row < NPROMPT ? x_prompt + (size_t)row * DM : x_sample + (size_t)(row - NPROMPT) * DM;
                float* hr = (float*)(ws + WS_H) + (size_t)row * DM;
#pragma unroll
                for (int bj = 0; bj < 2; ++bj) { const int col = col0 + bj * 128;
                    const f32x4 a = *(const GAS f32x4*)(xr + col), b = *(const GAS f32x4*)(xr + col + 4);
                    *(GAS f32x4*)(hr + col) = a + acc[ai][bj][m][0]; *(GAS f32x4*)(hr + col + 4) = b + acc[ai][bj][m][1]; }
            }
    }
};

constexpr int L_QROW = 0, L_WROW = 8192, L_PART = 8448, L_SC = 9216, L_SCAN = 9216 + 8256 * 4;
__device__ __forceinline__ unsigned fkey(float f) { const unsigned u = __builtin_bit_cast(unsigned, f); return (u & 0x80000000u) ? ~u : (u | 0x80000000u); }
__device__ __forceinline__ void p2_select_row(Frame& F, int r) {
    const int tid = F.tid, lane = F.lane, wave = F.wave;
    LAS unsigned char* L = F.lds;
    const bool samp = r >= NPROMPT;
    const int bd = samp ? (r - NPROMPT) / DS : 0, tt = samp ? (r - NPROMPT) % DS : (r % SEQ), bq = samp ? 0 : r / SEQ;
    const int nkeys = samp ? PAST + tt + 1 : tt + 1;
    int* selrow = (int*)(F.ws + WS_SEL) + (size_t)r * TOPK;
    if (nkeys <= TOPK) {
        for (int j = tid; j < TOPK; j += 512) selrow[j] = j < nkeys ? j : -1;
        return;
    }
    { const GAS u32x4* src = (const GAS u32x4*)((const f16*)(F.ws + WS_QI) + (size_t)r * 4096); ((LAS u32x4*)(L + L_QROW))[tid] = src[tid];
      if (tid < 32) ((LAS float*)(L + L_WROW))[tid] = ((const float*)(F.ws + WS_WI))[(size_t)r * 32 + tid]; }
    __syncthreads();
    LAS float* SC = (LAS float*)(L + L_SC);
    for (int s = tid; s < nkeys; s += 512) {
        f16x2 kk[64];
        if (!samp) { const GAS u32x4* kp = (const GAS u32x4*)((const f16*)(F.ws + WS_KI) + (size_t)(bq * SEQ + s) * IDIM);
#pragma unroll
            for (int i = 0; i < 16; ++i) { const u32x4 w = kp[i]; kk[4 * i] = as_h2(w.x); kk[4 * i + 1] = as_h2(w.y); kk[4 * i + 2] = as_h2(w.z); kk[4 * i + 3] = as_h2(w.w); }
        } else if (s >= PAST) { const GAS u32x4* kp = (const GAS u32x4*)((const f16*)(F.ws + WS_KI) + (size_t)(NPROMPT + bd * DS + (s - PAST)) * IDIM);
#pragma unroll
            for (int i = 0; i < 16; ++i) { const u32x4 w = kp[i]; kk[4 * i] = as_h2(w.x); kk[4 * i + 1] = as_h2(w.y); kk[4 * i + 2] = as_h2(w.z); kk[4 * i + 3] = as_h2(w.w); }
        } else { const int pg = F.page_table[bd * NPAGES + (s >> 7)]; const GAS f32x4* kp = (const GAS f32x4*)(F.cache_ik + ((size_t)pg * PAGE + (s & 127)) * IDIM);
#pragma unroll
            for (int i = 0; i < 32; ++i) { const f32x4 w = kp[i]; f16x2 a, b; a.x = (f16)w.x; a.y = (f16)w.y; b.x = (f16)w.z; b.y = (f16)w.w; kk[2 * i] = a; kk[2 * i + 1] = b; }
        }
        float score = 0.f;
        for (int h = 0; h < IH; ++h) {
            const LAS u32x4* qh = (const LAS u32x4*)(L + L_QROW + h * 256); float a = 0.f;
#pragma unroll
            for (int i = 0; i < 16; ++i) { const u32x4 w = qh[i];
                a = __builtin_amdgcn_fdot2(as_h2(w.x), kk[4 * i], a, false); a = __builtin_amdgcn_fdot2(as_h2(w.y), kk[4 * i + 1], a, false);
                a = __builtin_amdgcn_fdot2(as_h2(w.z), kk[4 * i + 2], a, false); a = __builtin_amdgcn_fdot2(as_h2(w.w), kk[4 * i + 3], a, false); }
            score += ((const LAS float*)(L + L_WROW))[h] * fmaxf(a, 0.f);
        }
        ((LAS unsigned*)SC)[s] = fkey(score);
    }
    __syncthreads();
    LAS unsigned* KEY = (LAS unsigned*)(L + L_SC); LAS unsigned* PART = (LAS unsigned*)(L + L_PART);
    unsigned prefix = 0u;
    for (int bit = 31; bit >= 0; --bit) {
        const unsigned cand = prefix | (1u << bit); unsigned c = 0;
        for (int s = tid; s < nkeys; s += 512) c += KEY[s] >= cand ? 1u : 0u;
#pragma unroll
        for (int o = 1; o < 64; o <<= 1) c += __shfl_xor(c, o);
        const int pb = (bit & 1) * 8;
        if (lane == 0) PART[pb + wave] = c;
        __syncthreads();
        unsigned tot = 0;
#pragma unroll
        for (int w = 0; w < 8; ++w) tot += PART[pb + w];
        if (tot >= (unsigned)TOPK) prefix = cand;
        if (tot == (unsigned)TOPK) break;
    }
    __syncthreads();
    const int PER = (nkeys + 511) / 512; const int s0 = tid * PER, s1 = (s0 + PER) < nkeys ? (s0 + PER) : nkeys;
    int c = 0; for (int s = s0; s < s1; ++s) c += KEY[s] >= prefix ? 1 : 0;
    int inc = c;
#pragma unroll
    for (int o = 1; o < 64; o <<= 1) { const int y = __shfl_up(inc, o); if (lane >= o) inc += y; }
    LAS int* SCAN = (LAS int*)(L + L_SCAN);
    if (lane == 63) SCAN[wave] = inc;
    __syncthreads();
    int base = 0;
#pragma unroll
    for (int w = 0; w < 8; ++w) base += (w < wave) ? SCAN[w] : 0;
    int pos = base + inc - c;
    for (int s = s0; s < s1; ++s) if (KEY[s] >= prefix) { if (pos < TOPK) selrow[pos] = s; ++pos; }
    __syncthreads();
}
__device__ __forceinline__ void p2_pool_diff(Frame& F) {
    const float* U = (const float*)(F.ws + WS_U); f16* D = (f16*)(F.ws + WS_D);
    const size_t total = (size_t)NT * (PW / 4);
    for (size_t i = (size_t)blockIdx.x * 512 + F.tid; i < total; i += (size_t)F.G * 512) {
        const int r = (int)(i / (PW / 4)), c4 = (int)(i % (PW / 4)) * 4; const int g = c4 / PGRP, win = 2 << g;
        f32x4 sum = (f32x4){0.f, 0.f, 0.f, 0.f}, self; float inv;
        if (r < NPROMPT) { const int t = r % SEQ; const int cnt = (t + 1) < win ? (t + 1) : win; inv = 1.0f / (float)cnt;
            self = *(const GAS f32x4*)(U + (size_t)r * PW + c4);
            for (int j = 0; j < cnt; ++j) sum += *(const GAS f32x4*)(U + (size_t)(r - j) * PW + c4);
        } else { const int q = r - NPROMPT, bd = q / DS, t = q % DS; inv = 1.0f / (float)win;
            self = *(const GAS f32x4*)(U + (size_t)r * PW + c4);
            for (int j = 0; j < win; ++j) { const int tj = t - j;
                sum += tj >= 0 ? *(const GAS f32x4*)(U + (size_t)(r - j) * PW + c4) : *(const GAS f32x4*)(F.state_pool + ((size_t)bd * PSTATE + (PSTATE + tj)) * PW + c4); }
        }
        const f32x4 d = sum * inv - self; u32x2 w; w.x = pkh(d.x, d.y); w.y = pkh(d.z, d.w);
        *(GAS u32x2*)(D + (size_t)r * PW + c4) = w;
    }
    const size_t np = (size_t)NB * PSTATE * (PW / 4), nsm = (size_t)DB * PSTATE * (PW / 4);
    for (size_t i = (size_t)blockIdx.x * 512 + F.tid; i < np + nsm; i += (size_t)F.G * 512) {
        if (i < np) { const int c4 = (int)(i % (PW / 4)) * 4, q = (int)(i / (PW / 4)), b = q / PSTATE, k = q % PSTATE;
            *(GAS f32x4*)(F.out + OFF_PSP + (size_t)q * PW + c4) = *(const GAS f32x4*)(U + (size_t)(b * SEQ + SEQ - PSTATE + k) * PW + c4);
        } else { const size_t j = i - np; const int c4 = (int)(j % (PW / 4)) * 4, q = (int)(j / (PW / 4)), bd = q / PSTATE, k = q % PSTATE;
            const f32x4 v = k < 7 ? *(const GAS f32x4*)(F.state_pool + ((size_t)bd * PSTATE + 8 + k) * PW + c4) : *(const GAS f32x4*)(U + (size_t)(NPROMPT + bd * DS + (k - 7)) * PW + c4);
            *(GAS f32x4*)(F.out + OFF_PSS + (size_t)q * PW + c4) = v; }
    }
}

constexpr int A_SEL = 0, A_BUCK = 1024, A_LG = 2048, A_PART = 18432;
__device__ __forceinline__ const float* kv_row_ptr(const Frame& F, bool samp, int bq, int bd, int pos, bool isv) {
    if (!samp) return F.out + (isv ? OFF_VP : OFF_KP) + (size_t)(bq * SEQ + pos) * KVW;
    if (pos >= PAST) return F.out + (isv ? OFF_VS : OFF_KS) + (size_t)(bd * DS + pos - PAST) * KVW;
    const int pg = F.page_table[bd * NPAGES + (pos >> 7)];
    return (isv ? F.cache_v : F.cache_k) + ((size_t)pg * PAGE + (pos & 127)) * KVW;
}
__device__ __forceinline__ void p3_attend_row(Frame& F, int r) {
    const int tid = F.tid, lane = F.lane, wave = F.wave; LAS unsigned char* L = F.lds;
    const bool samp = r >= NPROMPT;
    const int bd = samp ? (r - NPROMPT) / DS : 0, tt = samp ? (r - NPROMPT) % DS : (r % SEQ), bq = samp ? 0 : r / SEQ;
    const int qpos = samp ? PAST + tt : tt;
    LAS int* SELL = (LAS int*)(L + A_SEL); LAS int* BUCK = (LAS int*)(L + A_BUCK); LAS float* LG = (LAS float*)(L + A_LG); LAS float* PARTO = (LAS float*)(L + A_PART);
    if (tid < TOPK) SELL[tid] = ((const int*)(F.ws + WS_SEL))[(size_t)r * TOPK + tid];
    if (tid >= 256 && tid < 384) { const int d = tid - 256; int bk = d;
        if (d >= 16) { bk = 16 + (int)(__logf((float)d * (1.0f / 16.0f)) * (16.0f / 2.0794415416798357f)); bk = bk < 31 ? bk : 31; }
        BUCK[d] = bk; }
    const int g = lane >> 4, dl = (lane & 15) * 8;
    float q[4][8];
#pragma unroll
    for (int hh = 0; hh < 4; ++hh) { const f16x8 v = *(const GAS f16x8*)((const f16*)(F.ws + WS_Q) + (size_t)r * ATTW + (4 * g + hh) * HD + dl);
#pragma unroll
        for (int e = 0; e < 8; ++e) q[hh][e] = (float)v[e]; }
    __syncthreads();
    for (int i = 0; i < 32; ++i) {
        const int j = wave + 8 * i; const int pos = SELL[j];
        float part[4] = {0.f, 0.f, 0.f, 0.f};
        if (pos >= 0) {
            const float* kp = kv_row_ptr(F, samp, bq, bd, pos, false) + 8 * lane;
            const f32x4 k0 = *(const GAS f32x4*)kp, k1 = *(const GAS f32x4*)(kp + 4);
#pragma unroll
            for (int hh = 0; hh < 4; ++hh) part[hh] = (q[hh][0] * k0.x + q[hh][1] * k0.y) + (q[hh][2] * k0.z + q[hh][3] * k0.w) + (q[hh][4] * k1.x + q[hh][5] * k1.y) + (q[hh][6] * k1.z + q[hh][7] * k1.w);
#pragma unroll
            for (int hh = 0; hh < 4; ++hh) { part[hh] += __shfl_xor(part[hh], 1); part[hh] += __shfl_xor(part[hh], 2); part[hh] += __shfl_xor(part[hh], 4); part[hh] += __shfl_xor(part[hh], 8); }
        }
        if ((lane & 15) < 4) { const int hh = lane & 3, head = 4 * g + hh; float lg = -1e30f;
            if (pos >= 0) { const int d = qpos - pos; const int bk = d < 128 ? BUCK[d < 0 ? 0 : d] : 31;
                const float pv = hh == 0 ? part[0] : (hh == 1 ? part[1] : (hh == 2 ? part[2] : part[3]));
                lg = pv + F.rel_bias[bk * NH + head]; }
            LG[head * TOPK + j] = lg; }
    }
    __syncthreads();
#pragma unroll
    for (int hq = 0; hq < 2; ++hq) { const int head = 2 * wave + hq; float v[4]; float mx = -3.0e38f;
#pragma unroll
        for (int i = 0; i < 4; ++i) { v[i] = LG[head * TOPK + lane + 64 * i]; mx = fmaxf(mx, v[i]); }
        mx = wave_max(mx); float s = 0.f;
#pragma unroll
        for (int i = 0; i < 4; ++i) { v[i] = __expf(v[i] - mx); s += v[i]; }
        s = wave_sum(s); const float inv = 1.0f / s;
#pragma unroll
        for (int i = 0; i < 4; ++i) LG[head * TOPK + lane + 64 * i] = v[i] * inv; }
    __syncthreads();
    float acc[4][8];
#pragma unroll
    for (int hh = 0; hh < 4; ++hh)
#pragma unroll
        for (int e = 0; e < 8; ++e) acc[hh][e] = 0.f;
    for (int i = 0; i < 32; ++i) {
        const int j = wave + 8 * i; const int pos = SELL[j];
        if (pos >= 0) {
            const float* vp = kv_row_ptr(F, samp, bq, bd, pos, true) + 8 * lane;
            const f32x4 v0 = *(const GAS f32x4*)vp, v1 = *(const GAS f32x4*)(vp + 4);
#pragma unroll
            for (int hh = 0; hh < 4; ++hh) { const float p = LG[(4 * g + hh) * TOPK + j];
                acc[hh][0] += p * v0.x; acc[hh][1] += p * v0.y; acc[hh][2] += p * v0.z; acc[hh][3] += p * v0.w;
                acc[hh][4] += p * v1.x; acc[hh][5] += p * v1.y; acc[hh][6] += p * v1.z; acc[hh][7] += p * v1.w; }
        }
    }
#pragma unroll
    for (int hh = 0; hh < 4; ++hh) { LAS f32x4* o = (LAS f32x4*)(PARTO + wave * 2048 + (4 * g + hh) * HD + dl);
        o[0] = (f32x4){acc[hh][0], acc[hh][1], acc[hh][2], acc[hh][3]}; o[1] = (f32x4){acc[hh][4], acc[hh][5], acc[hh][6], acc[hh][7]}; }
    __syncthreads();
    { f32x4 s = (f32x4){0.f, 0.f, 0.f, 0.f};
#pragma unroll
      for (int w = 0; w < 8; ++w) s += *(const LAS f32x4*)(PARTO + w * 2048 + tid * 4);
      const f16x4 ga = *(const GAS f16x4*)((const f16*)(F.ws + WS_GA) + (size_t)r * ATTW + tid * 4);
      u32x2 w; w.x = pkh(s.x * (float)ga[0], s.y * (float)ga[1]); w.y = pkh(s.z * (float)ga[2], s.w * (float)ga[3]);
      *(GAS u32x2*)((f16*)(F.ws + WS_MIX) + (size_t)r * DM + tid * 4) = w; }
    __syncthreads();
}

struct Args { const void* in[14]; float* out; unsigned char* ws; int ph_lo, ph_hi; };
constexpr int PER_PHASE = 6;
__global__ void __launch_bounds__(NWAVES * 64, 2) mk_fwd(Args args) {
    extern __shared__ __attribute__((aligned(16))) unsigned char lds[];
    Frame F;
    F.lds = (LAS unsigned char*)lds;
    F.tid = threadIdx.x; F.lane = F.tid & 63; F.wave = __builtin_amdgcn_readfirstlane(F.tid >> 6);
    F.G = gridDim.x; { const int bx = blockIdx.x; F.vcu = (F.G % 8 == 0) ? (bx % 8) * (F.G / 8) + bx / 8 : bx; }
    F.x_prompt = (const float*)args.in[0]; F.x_sample = (const float*)args.in[1]; F.cache_k = (const float*)args.in[2]; F.cache_v = (const float*)args.in[3];
    F.cache_ik = (const float*)args.in[4]; F.state_pool = (const float*)args.in[5]; F.page_table = (const int*)args.in[6]; F.rel_bias = (const float*)args.in[7];
    F.ln_g = (const float*)args.in[8]; F.w_in = (const float*)args.in[9]; F.w_pool = (const float*)args.in[10]; F.pool_scale = (const float*)args.in[11];
    F.w_out = (const float*)args.in[12]; F.final_g = (const float*)args.in[13];
    F.out = args.out; F.ws = args.ws;
    volatile LAS unsigned* MISC = (volatile LAS unsigned*)(F.lds + MISC_OFF);
    for (int u = F.tid; u < (LDS_BYTES - LDSCTL_OFF) / 4; u += NWAVES * 64) ((LAS unsigned*)(F.lds + LDSCTL_OFF))[u] = 0u;
    __syncthreads();
    unsigned* ctl = (unsigned*)(F.ws + WS_CTL);
    XcdBarrier bar; bar.bar = ctl + CW_BAR; bar.x = 0; bar.st = nullptr;
    if (MK_N_LAUNCHES != PER_PHASE) bar = xcd_barrier_post(ctl + CW_BAR, MISC + 8);
    const int lo = args.ph_lo, hi = args.ph_hi;
#define IN(k) (lo <= (k) && (k) < hi)
#define BOTH(k) (IN(k) && IN((k) + 1))
#define GRID_BAR() do { if (MK_N_LAUNCHES != PER_PHASE) xcd_barrier(bar); } while (0)

    if (IN(0)) { p0_prologue(F); if (BOTH(0)) GRID_BAR(); }

    if (IN(1)) {
        pg8::Gemm g{(const f16*)(F.ws + WS_XN), (const f16*)(F.ws + WS_WTIN), NT, INWP, DM, DM, DM, 0, 0};
        pg8::StaticOrder S; S.init(NT, INWP, F.G, (int)blockIdx.x);
        Epi1 E{F.out, F.ws};
        pg8::gemm_phase<Epi1>(F.lds + RING_OFF, g, S, E);
        if (BOTH(1)) GRID_BAR();
    }

    if (IN(2)) {
        for (int r = blockIdx.x; r < NT; r += F.G) p2_select_row(F, r);
        p2_pool_diff(F);
        if (BOTH(2)) GRID_BAR();
    }

    if (IN(3)) {
        for (int r = blockIdx.x; r < NT; r += F.G) p3_attend_row(F, r);
        {
            pg8::Gemm g{(const f16*)(F.ws + WS_D), (const f16*)(F.ws + WS_WTPOOL), NT, PW, PGRP, PW, PGRP, 1, PGRP};
            pg8::StaticOrder S; S.init(NT, PW, F.G, (int)blockIdx.x);
            EpiPool E{F.pool_scale, F.ws};
            pg8::gemm_phase<EpiPool>(F.lds + RING_OFF, g, S, E);
        }
        if (BOTH(3)) GRID_BAR();
    }

    if (IN(4)) {
        pg8::Gemm g{(const f16*)(F.ws + WS_MIX), (const f16*)(F.ws + WS_WTOUT), NT, DM, DM, DM, DM, 0, 0};
        pg8::StaticOrder S; S.init(NT, DM, F.G, (int)blockIdx.x);
        Epi2 E{F.x_prompt, F.x_sample, F.ws};
        pg8::gemm_phase<Epi2>(F.lds + RING_OFF, g, S, E);
        if (BOTH(4)) GRID_BAR();
    }

    if (IN(5)) {
        const int gw = F.vcu * NWAVES + F.wave, NGW = F.G * NWAVES;
        for (int m = gw; m < NT; m += NGW) {
            const GAS f32x4* hr = (const GAS f32x4*)((const float*)(F.ws + WS_H) + (size_t)m * DM) + F.lane;
            f32x4 v[16]; float s = 0.f;
#pragma unroll
            for (int j = 0; j < 16; ++j) { v[j] = hr[64 * j]; s += (v[j].x * v[j].x + v[j].y * v[j].y) + (v[j].z * v[j].z + v[j].w * v[j].w); }
            const float rstd = 1.0f / sqrtf(wave_sum(s) * (1.f / DM) + RMS_EPS);
            GAS f32x4* o = (GAS f32x4*)(F.out + (m < NPROMPT ? OFF_YP + (size_t)m * DM : OFF_YS + (size_t)(m - NPROMPT) * DM)) + F.lane;
            const GAS f32x4* gr = (const GAS f32x4*)F.final_g + F.lane;
#pragma unroll
            for (int j = 0; j < 16; ++j) o[64 * j] = v[j] * rstd * gr[64 * j];
        }
    }
#undef IN
#undef BOTH
#undef GRID_BAR
}

extern "C" void kernel_launch(void* const* d_in, const int* in_sizes, int n_in, void* d_out, int out_size, void* d_ws, size_t ws_size, hipStream_t stream) {
    static int grid = 0;
    if (grid == 0) {
        if (n_in != 14 || out_size != (int)OUT_TOTAL || ws_size < WS_END) { fprintf(stderr, "kernel_launch: unexpected shapes (n_in %d, out %d, ws %zu)\n", n_in, out_size, ws_size); grid = -1; return; }
        int dev = 0, cus = 0, per_cu = 0;
        if (hipGetDevice(&dev) != hipSuccess || hipDeviceGetAttribute(&cus, hipDeviceAttributeMultiprocessorCount, dev) != hipSuccess) { grid = -1; return; }
        if (hipFuncSetAttribute((const void*)mk_fwd, hipFuncAttributeMaxDynamicSharedMemorySize, LDS_BYTES) != hipSuccess) { fprintf(stderr, "kernel_launch: hipFuncSetAttribute failed\n"); grid = -1; return; }
        if (hipOccupancyMaxActiveBlocksPerMultiprocessor(&per_cu, (const void*)mk_fwd, NWAVES * 64, LDS_BYTES) != hipSuccess || per_cu < 1)
            fprintf(stderr, "kernel_launch: note: occupancy query reports %d workgroups per CU\n", per_cu);
        (void)hipGetLastError();
        grid = cus;
    }
    if (grid < 0) return;
    if (hipMemsetAsync((char*)d_ws + WS_CTL, 0, CTL_ZERO_BYTES, stream) != hipSuccess) { fprintf(stderr, "kernel_launch: memset failed\n"); return; }
    Args a{};
    for (int i = 0; i < 14; ++i) a.in[i] = d_in[i];
    a.out = (float*)d_out; a.ws = (unsigned char*)d_ws;
    const int nl = MK_N_LAUNCHES;
    for (int li = 0; li < nl; ++li) {
        a.ph_lo = (nl == PER_PHASE) ? li : 0; a.ph_hi = (nl == PER_PHASE) ? li + 1 : PER_PHASE;
        hipLaunchKernelGGL(mk_fwd, dim3(grid), dim3(NWAVES * 64), LDS_BYTES, stream, a);
        const hipError_t le = hipPeekAtLastError();
        if (le != hipSuccess) { fprintf(stderr, "kernel_launch: launch %d failed: %s\n", li, hipGetErrorName(le)); break; }
    }
}
```

```cpp
#include <hip/hip_runtime.h>
#include <cstdio>
#include <cstdint>

#ifndef DUP_PHASE
#define DUP_PHASE -1
#endif
#ifndef MK_N_LAUNCHES
#define MK_N_LAUNCHES 1
#endif

#define LAS __attribute__((address_space(3)))
#define GAS __attribute__((address_space(1)))
typedef _Float16 f16;
typedef _Float16 f16x8 __attribute__((ext_vector_type(8)));
typedef _Float16 f16x4 __attribute__((ext_vector_type(4)));
typedef _Float16 f16x2 __attribute__((ext_vector_type(2)));
typedef float f32x4 __attribute__((ext_vector_type(4)));
typedef float f32x2 __attribute__((ext_vector_type(2)));
typedef float f32x16 __attribute__((ext_vector_type(16)));
typedef unsigned u32x4 __attribute__((ext_vector_type(4)));
typedef unsigned u32x2 __attribute__((ext_vector_type(2)));

constexpr int DM = 4096, NB = 4, SEQ = 2048, DB = 32, DS = 8, PAST = 8192, PAGE = 128, NPAGES = 64;
constexpr int NPROMPT = NB * SEQ, NSAMP = DB * DS, NT = NPROMPT + NSAMP;
constexpr int ATTW = 2048, KVW = 512, HD = 128, NH = 16, NKV = 4, IH = 32, IDIM = 128, TOPK = 256, PW = 2048, PGRP = 512, PSTATE = 15;
constexpr int INW = 13472, INWP = 13568;
constexpr float RMS_EPS = 1e-6f;
constexpr size_t OFF_YP = 0, OFF_YS = 33554432, OFF_KP = 34603008, OFF_VP = 38797312, OFF_IKP = 42991616, OFF_PSP = 44040192,
                 OFF_KS = 44163072, OFF_VS = 44294144, OFF_IKS = 44425216, OFF_PSS = 44457984, OUT_TOTAL = 45441024;
constexpr size_t MiB = 1u << 20;
constexpr size_t WS_CTL = 0, CTL_ZERO_BYTES = 1 * MiB;
constexpr size_t WS_WTIN = 2 * MiB;
constexpr size_t WS_WTOUT = 110 * MiB;
constexpr size_t WS_WTPOOL = 142 * MiB;
constexpr size_t WS_XN = 144 * MiB;
constexpr size_t WS_Q = 210 * MiB;
constexpr size_t WS_KH = 243 * MiB;
constexpr size_t WS_VH = 252 * MiB;
constexpr size_t WS_GA = 261 * MiB;
constexpr size_t WS_QI = 294 * MiB;
constexpr size_t WS_WI = 360 * MiB;
constexpr size_t WS_KI = 362 * MiB;
constexpr size_t WS_U = 365 * MiB;
constexpr size_t WS_GB = 431 * MiB;
constexpr size_t WS_D = 464 * MiB;
constexpr size_t WS_MIX = 497 * MiB;
constexpr size_t WS_H = 563 * MiB;
constexpr size_t WS_SEL = 695 * MiB;
constexpr size_t WS_S = 704 * MiB;
constexpr size_t WS_SELM = 768 * MiB;
constexpr size_t WS_VT = 772 * MiB;
constexpr size_t WS_S2 = 780 * MiB;
constexpr size_t WS_END = 790 * MiB;
constexpr int CW_BAR = 4096;

namespace pg8 {
constexpr int BM = 256, BK = 64, HALF = 128, HTB = HALF * BK * 2, STAGE_BYTES = 8 * HTB, NXCD = 8, WGM = 8;
__host__ __device__ __forceinline__ int lds_byte(int r, int c) { const int st = (r >> 4) * 2 + (c >> 5), rr = r & 15, cc = c & 31, ob = rr * 64 + cc * 2; return st * 1024 + (ob ^ (((ob >> 9) & 1) << 5)); }
__host__ __device__ __forceinline__ void stage_rc(int b, int& R, int& C) { const int st = b / 1024, sb = b % 1024, swz = sb ^ (((sb >> 9) & 1) << 5); R = (st >> 1) * 16 + swz / 64; C = (st & 1) * 32 + (swz % 64) / 2; }
__host__ __device__ __forceinline__ int perm32(int rho) { const int n = rho >> 4, i = rho & 15; return 8 * (i >> 2) + 4 * n + (i & 3); }
struct Unit { int pm, pn; };
struct Gemm { const f16* A; const f16* Bt; int M, N, K, lda, ldb; int a_grp_shift; int a_grp_cols; };
struct StaticOrder {
    int nM, nN, nwg, G, c;
    __host__ __device__ void init(int M, int N, int G_, int c_) { nM = M / BM; nN = N / BM; nwg = nM * nN; G = G_; c = c_; }
    __host__ __device__ bool next(int i, Unit& u) const {
        const long L = (long)i * G + c; if (L >= nwg) return false;
        int wgid = (int)L; { const int q = nwg / NXCD, r = nwg % NXCD, xcd = wgid % NXCD, off = wgid / NXCD; wgid = (xcd < r ? xcd * (q + 1) : r * (q + 1) + (xcd - r) * q) + off; }
        const int nig = WGM * nN, gid = wgid / nig, fm = gid * WGM, gsz = (nM - fm) < WGM ? (nM - fm) : WGM;
        u.pm = fm + ((wgid % nig) % gsz); u.pn = (wgid % nig) / gsz; return true;
    }
};
template <class Epi, bool ALIGN_EPI = true, bool SP2 = true>
__device__ __forceinline__ void gemm_phase(LAS unsigned char* lds, const Gemm g, const StaticOrder& S, const Epi& E) {
    const int tid = threadIdx.x, wid = __builtin_amdgcn_readfirstlane(tid >> 6), lane = tid & 63, wr = wid >> 2, wc = wid & 3, fr = lane & 15, fq = lane >> 4;
    const int K = g.K, nt = K / BK;
    unsigned voffA[2], voffB[2];
#pragma unroll
    for (int i = 0; i < 2; ++i) { int R, C; stage_rc(tid * 16 + i * 8192, R, C); const int Rb = (R & ~31) + perm32(R & 31);
        voffA[i] = (unsigned)(R * g.lda + C) * 2u; voffB[i] = (unsigned)(Rb * g.ldb + C) * 2u; }
    const size_t kstep = (size_t)(BK * 2);
    const size_t hstepA = (size_t)HALF * g.lda * 2, hstepB = (size_t)HALF * g.ldb * 2;
    const size_t tstepA = 2 * hstepA, tstepB = 2 * hstepB;
    const unsigned ldsw = (unsigned)wid * 1024u;
    const int aoff = lds_byte(wr * 64 + fr, fq * 8), boff = lds_byte(wc * 32 + fr, fq * 8);
#define PG8_SA(b, h) (((b) * 2 + (h)) * HTB)
#define PG8_SB(b, h) ((4 + (b) * 2 + (h)) * HTB)
#define PG8_STAGE(bufoff, gbase, voff) do { _Pragma("unroll") for (int _i = 0; _i < 2; ++_i) \
        __builtin_amdgcn_global_load_lds((const unsigned*)((const char*)(gbase) + (voff)[_i]), (LAS unsigned*)(lds + (bufoff) + ldsw + _i * 8192), 16, 0, 0); } while (0)
#define PG8_LDA(dst, b, h) do { _Pragma("unroll") for (int m = 0; m < 4; ++m) _Pragma("unroll") for (int k = 0; k < 2; ++k) dst[m][k] = *(const LAS f16x8*)(lds + PG8_SA(b, h) + aoff + m * 2048 + k * 1024); } while (0)
#define PG8_LDB(dst, b, h) do { _Pragma("unroll") for (int n = 0; n < 2; ++n) _Pragma("unroll") for (int k = 0; k < 2; ++k) dst[n][k] = *(const LAS f16x8*)(lds + PG8_SB(b, h) + boff + n * 2048 + k * 1024); } while (0)
#define PG8_MMA(ai, bj, At, Bt) do { __builtin_amdgcn_s_setprio(1); _Pragma("unroll") for (int m = 0; m < 4; ++m) _Pragma("unroll") for (int n = 0; n < 2; ++n) _Pragma("unroll") for (int k = 0; k < 2; ++k) \
        acc[ai][bj][m][n] = __builtin_amdgcn_mfma_f32_16x16x32_f16(Bt[n][k], At[m][k], acc[ai][bj][m][n], 0, 0, 0); __builtin_amdgcn_s_setprio(0); } while (0)
#define PG8_WAIT_V(n) asm volatile("s_waitcnt vmcnt(" #n ")" ::: "memory")
#define PG8_WAIT_L(n) asm volatile("s_waitcnt lgkmcnt(" #n ")" ::: "memory")
#define PG8_BAR __builtin_amdgcn_s_barrier()
#define PG8_SCHED __builtin_amdgcn_sched_barrier(0)
#define PG8_AOFF(u) ((size_t)(u).pm * tstepA + (g.a_grp_cols ? (size_t)(((u).pn >> g.a_grp_shift) * g.a_grp_cols) * 2 : (size_t)0))
    Unit cur, nxt; int ui = 0;
    if (!S.next(0, cur)) return;
    f32x4 acc[2][2][4][2];
#pragma unroll
    for (int a = 0; a < 2; ++a)
#pragma unroll
        for (int b = 0; b < 2; ++b)
#pragma unroll
            for (int m = 0; m < 4; ++m)
#pragma unroll
                for (int n = 0; n < 2; ++n) acc[a][b][m][n] = (f32x4){0.f, 0.f, 0.f, 0.f};
    f16x8 At[4][2], B0[2][2], B1[2][2];
    const char* cA = (const char*)g.A + PG8_AOFF(cur); const char* cB = (const char*)g.Bt + (size_t)cur.pn * tstepB;
    if constexpr (SP2) {
        PG8_STAGE(PG8_SB(0, 0), cB, voffB); PG8_STAGE(PG8_SB(0, 1), cB + hstepB, voffB); PG8_STAGE(PG8_SA(0, 0), cA, voffA); PG8_STAGE(PG8_SA(0, 1), cA + hstepA, voffA);
        if (wr == 1) PG8_BAR;
        PG8_WAIT_V(2); PG8_BAR;
        PG8_STAGE(PG8_SB(1, 0), cB + kstep, voffB); PG8_STAGE(PG8_SA(1, 0), cA + kstep, voffA); PG8_STAGE(PG8_SB(1, 1), cB + hstepB + kstep, voffB);
        PG8_WAIT_V(6); PG8_BAR;
    } else {
        PG8_STAGE(PG8_SB(0, 0), cB, voffB); PG8_STAGE(PG8_SA(0, 0), cA, voffA); PG8_STAGE(PG8_SB(0, 1), cB + hstepB, voffB); PG8_STAGE(PG8_SA(0, 1), cA + hstepA, voffA);
        if (wr == 1) PG8_BAR;
        PG8_WAIT_V(4); PG8_BAR;
        PG8_STAGE(PG8_SB(1, 0), cB + kstep, voffB); PG8_STAGE(PG8_SA(1, 0), cA + kstep, voffA); PG8_STAGE(PG8_SB(1, 1), cB + hstepB + kstep, voffB);
        PG8_WAIT_V(6); PG8_BAR;
    }
    for (;;) {
        const bool has_next = S.next(ui + 1, nxt);
        const char* nA = has_next ? (const char*)g.A + PG8_AOFF(nxt) : cA; const char* nB = has_next ? (const char*)g.Bt + (size_t)nxt.pn * tstepB : cB;
        for (int t = 0; t < nt; t += 2) {
            const bool last = (t == nt - 2);
            const char* a1 = cA + (size_t)(t + 1) * kstep;
            const char* a2 = last ? nA : cA + (size_t)(t + 2) * kstep; const char* b2 = last ? nB : cB + (size_t)(t + 2) * kstep;
            const char* a3 = a2 + kstep; const char* b3 = b2 + kstep;
            if constexpr (SP2) {
            PG8_LDB(B0, 0, 0); PG8_LDB(B1, 0, 1); PG8_SCHED; PG8_LDA(At, 0, 0); PG8_STAGE(PG8_SA(1, 1), a1 + hstepA, voffA);
            PG8_WAIT_V(8); PG8_WAIT_L(0); PG8_BAR; PG8_MMA(0, 0, At, B0); PG8_MMA(0, 1, At, B1); PG8_BAR; PG8_SCHED;
            PG8_LDA(At, 0, 1); PG8_STAGE(PG8_SB(0, 0), b2, voffB); PG8_STAGE(PG8_SB(0, 1), b2 + hstepB, voffB); PG8_STAGE(PG8_SA(0, 0), a2, voffA);
            PG8_WAIT_V(8); PG8_WAIT_L(0); PG8_BAR; PG8_MMA(1, 0, At, B0); PG8_MMA(1, 1, At, B1); PG8_BAR; PG8_SCHED;
            PG8_LDB(B0, 1, 0); PG8_LDB(B1, 1, 1); PG8_SCHED; PG8_LDA(At, 1, 0); PG8_STAGE(PG8_SA(0, 1), a2 + hstepA, voffA);
            PG8_WAIT_V(8); PG8_WAIT_L(0); PG8_BAR; PG8_MMA(0, 0, At, B0); PG8_MMA(0, 1, At, B1); PG8_BAR; PG8_SCHED;
            PG8_LDA(At, 1, 1); PG8_STAGE(PG8_SB(1, 0), b3, voffB); PG8_STAGE(PG8_SB(1, 1), b3 + hstepB, voffB); PG8_STAGE(PG8_SA(1, 0), a3, voffA);
            PG8_WAIT_V(8); PG8_WAIT_L(0); PG8_BAR; PG8_MMA(1, 0, At, B0); PG8_MMA(1, 1, At, B1); PG8_BAR; PG8_SCHED;
            } else {
            PG8_LDB(B0, 0, 0); PG8_SCHED; PG8_LDA(At, 0, 0); PG8_STAGE(PG8_SA(1, 1), a1 + hstepA, voffA);
            PG8_WAIT_L(8); PG8_BAR; PG8_WAIT_L(0); PG8_MMA(0, 0, At, B0); PG8_BAR; PG8_SCHED;
            PG8_LDB(B1, 0, 1); PG8_STAGE(PG8_SB(0, 0), b2, voffB);
            PG8_BAR; PG8_WAIT_L(0); PG8_MMA(0, 1, At, B1); PG8_BAR;
            PG8_LDA(At, 0, 1); PG8_STAGE(PG8_SA(0, 0), a2, voffA);
            PG8_BAR; PG8_WAIT_L(0); PG8_MMA(1, 0, At, B0); PG8_BAR; PG8_SCHED;
            PG8_STAGE(PG8_SB(0, 1), b2 + hstepB, voffB);
            PG8_WAIT_V(6); PG8_BAR; PG8_MMA(1, 1, At, B1); PG8_BAR;
            PG8_LDB(B0, 1, 0); PG8_SCHED; PG8_LDA(At, 1, 0); PG8_STAGE(PG8_SA(0, 1), a2 + hstepA, voffA);
            PG8_WAIT_L(8); PG8_BAR; PG8_WAIT_L(0); PG8_MMA(0, 0, At, B0); PG8_BAR; PG8_SCHED;
            PG8_LDB(B1, 1, 1); PG8_STAGE(PG8_SB(1, 0), b3, voffB);
            PG8_BAR; PG8_WAIT_L(0); PG8_MMA(0, 1, At, B1); PG8_BAR;
            PG8_LDA(At, 1, 1); PG8_STAGE(PG8_SA(1, 0), a3, voffA);
            PG8_BAR; PG8_WAIT_L(0); PG8_MMA(1, 0, At, B0); PG8_BAR; PG8_SCHED;
            PG8_STAGE(PG8_SB(1, 1), b3 + hstepB, voffB);
            PG8_WAIT_V(6); PG8_BAR; PG8_MMA(1, 1, At, B1); PG8_BAR;
            }
        }
        if constexpr (ALIGN_EPI) { if (wr == 0) PG8_BAR; }
        E(acc, cur, wr, wc, fr, fq);
        if (!has_next) break;
#pragma unroll
        for (int a = 0; a < 2; ++a)
#pragma unroll
            for (int b = 0; b < 2; ++b)
#pragma unroll
                for (int m = 0; m < 4; ++m)
#pragma unroll
                    for (int n = 0; n < 2; ++n) acc[a][b][m][n] = (f32x4){0.f, 0.f, 0.f, 0.f};
        cur = nxt; cA = nA; cB = nB; ++ui;
        if constexpr (ALIGN_EPI) { if (wr == 1) PG8_BAR; }
    }
    PG8_WAIT_V(0);
    if constexpr (!ALIGN_EPI) { if (wr == 0) PG8_BAR; }
    PG8_BAR;
#undef PG8_SA
#undef PG8_SB
#undef PG8_STAGE
#undef PG8_LDA
#undef PG8_LDB
#undef PG8_MMA
#undef PG8_WAIT_V
#undef PG8_WAIT_L
#undef PG8_BAR
#undef PG8_SCHED
#undef PG8_AOFF
}
}

constexpr int RING_OFF = 0, RING_BYTES = 131072;
constexpr int LDSCTL_OFF = RING_BYTES, MISC_OFF = LDSCTL_OFF + 320;
constexpr int LDS_BYTES = 147456;
constexpr int NWAVES = 8;

#define LDS_WAIT() asm volatile("s_waitcnt lgkmcnt(0)" ::: "memory")
#define VM_WAIT() asm volatile("s_waitcnt vmcnt(0)" ::: "memory")
__device__ __forceinline__ unsigned pkh(float lo, float hi) { f16x2 v; v.x = (f16)lo; v.y = (f16)hi; return __builtin_bit_cast(unsigned, v); }
__device__ __forceinline__ f16x2 as_h2(unsigned u) { return __builtin_bit_cast(f16x2, u); }
__device__ __forceinline__ float silu_f(float x) { return x * __builtin_amdgcn_rcpf(1.0f + __expf(-x)); }

#define XB_TMO      128
#define XB_XCNT(j)  (256  + 64 * (j))
#define XB_XSUB(j)  (1280 + 64 * (j))
#define XB_XGEN(j)  (2304 + 64 * (j))
#define XB_TOP      3328
#define XB_TOPGEN   3392
#define XCD_BAR_WORDS 3456
#define XB_SPIN_CAP (1u << 18)
__device__ __forceinline__ unsigned xb_ld(unsigned* p)              { return __hip_atomic_load(p, __ATOMIC_RELAXED, __HIP_MEMORY_SCOPE_AGENT); }
__device__ __forceinline__ unsigned xb_add(unsigned* p, unsigned v) { return __hip_atomic_fetch_add(p, v, __ATOMIC_RELAXED, __HIP_MEMORY_SCOPE_AGENT); }
__device__ __forceinline__ unsigned xb_xcc_id() { return (unsigned)__builtin_amdgcn_s_getreg((3 << 11) | 20) & 0xFu; }
#define XB_SPIN(cond, bar) do { unsigned _sp = 0; while (cond) { __builtin_amdgcn_s_sleep(1); \
    if ((++_sp & 255u) == 0u) { if (xb_ld(&(bar)[XB_TMO])) break; if (_sp > XB_SPIN_CAP) { atomicAdd(&(bar)[XB_TMO], 1u); break; } } } } while (0)
struct XcdBarrier { unsigned* bar; unsigned x; volatile LAS unsigned* st; };
__device__ __forceinline__ XcdBarrier xcd_barrier_post(unsigned* bar, volatile LAS unsigned* st) {
    XcdBarrier b; b.bar = bar; b.x = xb_xcc_id(); b.st = st;
    if (threadIdx.x == 0) (void)xb_add(&bar[XB_XCNT(b.x)], 1u);
    return b;
}
__device__ __forceinline__ void xcd_barrier_complete(unsigned* bar, unsigned x, unsigned& nloc, unsigned& nx) {
    const unsigned G = gridDim.x * gridDim.y * gridDim.z;
    unsigned sum, cnt, mine, sp = 0u;
    for (;;) {
        sum = 0u; cnt = 0u; mine = 0u;
#pragma unroll
        for (unsigned j = 0; j < 16; ++j) { const unsigned c = xb_ld(&bar[XB_XCNT(j)]); sum += c; cnt += (c > 0u) ? 1u : 0u; mine = (j == x) ? c : mine; }
        if (sum == G) break;
        __builtin_amdgcn_s_sleep(1);
        if ((++sp & 255u) == 0u) { if (xb_ld(&bar[XB_TMO])) break; if (sp > XB_SPIN_CAP) { atomicAdd(&bar[XB_TMO], 1u); break; } }
    }
    nloc = mine > 0u ? mine : 1u; nx = cnt > 0u ? cnt : 1u;
}
__device__ __forceinline__ void xcd_barrier(const XcdBarrier& b) {
    asm volatile("s_waitcnt vmcnt(0)" ::: "memory");
    __syncthreads();
    if (threadIdx.x == 0) {
        unsigned* bar = b.bar;
        __builtin_amdgcn_s_waitcnt(0);
        unsigned nloc = b.st[0], nx = b.st[1];
        if (nloc == 0u) { xcd_barrier_complete(bar, b.x, nloc, nx); b.st[0] = nloc; b.st[1] = nx; }
        const unsigned old = xb_add(&bar[XB_XSUB(b.x)], 1u);
        const unsigned gen = old / nloc;
        if (old + 1u == (gen + 1u) * nloc) {
            __builtin_amdgcn_fence(__ATOMIC_RELEASE, "agent");
            asm volatile("s_waitcnt vmcnt(0)" ::: "memory");
            const unsigned og = xb_add(&bar[XB_TOP], 1u);
            const unsigned tg = og / nx;
            if (og + 1u == (tg + 1u) * nx) xb_add(&bar[XB_TOPGEN], 1u);
            else XB_SPIN(xb_ld(&bar[XB_TOPGEN]) == tg, bar);
            __builtin_amdgcn_fence(__ATOMIC_ACQUIRE, "agent");
            xb_add(&bar[XB_XGEN(b.x)], 1u);
            asm volatile("s_waitcnt vmcnt(0)" ::: "memory");
        } else {
            XB_SPIN(xb_ld(&bar[XB_XGEN(b.x)]) == gen, bar);
            __builtin_amdgcn_fence(__ATOMIC_ACQUIRE, "agent");
            asm volatile("s_waitcnt vmcnt(0)" ::: "memory");
        }
    }
    __syncthreads();
}

struct Frame {
    LAS unsigned char* lds;
    int tid, lane, wave, vcu, G;
    const float *x_prompt, *x_sample, *cache_k, *cache_v, *cache_ik, *state_pool; const int* page_table;
    const float *rel_bias, *ln_g, *w_in, *w_pool, *pool_scale, *w_out, *final_g;
    float* out; unsigned char* ws;
};
__device__ __forceinline__ const float* x_row(const Frame& F, int r) { return r < NPROMPT ? F.x_prompt + (size_t)r * DM : F.x_sample + (size_t)(r - NPROMPT) * DM; }
__device__ __forceinline__ float wave_sum(float v) {
#pragma unroll
    for (int o = 1; o < 64; o <<= 1) v += __shfl_xor(v, o);
    return v;
}
__device__ __forceinline__ float wave_max(float v) {
#pragma unroll
    for (int o = 1; o < 64; o <<= 1) v = fmaxf(v, __shfl_xor(v, o));
    return v;
}

struct TrItem { const float* W; f16* WT; int K, N, src_n0, dst_row0, k0; };
__device__ __forceinline__ void tr_load(const TrItem& t, f32x4 (&v)[8], int lane) {
    const int r = lane >> 3, c = lane & 7;
#pragma unroll
    for (int i = 0; i < 8; ++i) v[i] = t.src_n0 >= 0 ? *(const GAS f32x4*)(t.W + (size_t)(t.k0 + r + 8 * i) * t.N + t.src_n0 + 4 * c) : (f32x4){0.f, 0.f, 0.f, 0.f};
}
__device__ __forceinline__ void tr_finish(const TrItem& t, const f32x4 (&v)[8], LAS float* scr, int lane) {
    const int r = lane >> 3, c4 = (lane & 7) * 4;
#pragma unroll
    for (int i = 0; i < 8; ++i) { LAS float* p = scr + (r + 8 * i) * 33 + c4; p[0] = v[i].x; p[1] = v[i].y; p[2] = v[i].z; p[3] = v[i].w; }
    LDS_WAIT(); asm volatile("" ::: "memory");
    const int c = lane & 7;
#pragma unroll
    for (int j = 0; j < 4; ++j) { const int n = (lane >> 3) + 8 * j; const LAS float* s = scr + (8 * c) * 33 + n;
        u32x4 o; o.x = pkh(s[0 * 33], s[1 * 33]); o.y = pkh(s[2 * 33], s[3 * 33]); o.z = pkh(s[4 * 33], s[5 * 33]); o.w = pkh(s[6 * 33], s[7 * 33]);
        *(GAS u32x4*)(t.WT + (size_t)(t.dst_row0 + n) * t.K + t.k0 + 8 * c) = o; }
    LDS_WAIT(); asm volatile("" ::: "memory");
}
__device__ __forceinline__ TrItem p0_item(const Frame& F, int it) {
    constexpr int NBI = INWP / 32, I_IN = 64 * NBI, I_OUT = 64 * 128;
    TrItem t; int r = it;
    if (r < I_IN) { const int kb = r / NBI, nb = r % NBI, n0 = 32 * nb; t.W = F.w_in; t.WT = (f16*)(F.ws + WS_WTIN); t.K = DM; t.N = INW; t.src_n0 = n0 < 9376 ? n0 : (n0 < 9472 ? -1 : n0 - 96); t.dst_row0 = n0; t.k0 = 64 * kb; return t; }
    r -= I_IN;
    if (r < I_OUT) { const int kb = r / 128, nb = r % 128; t.W = F.w_out; t.WT = (f16*)(F.ws + WS_WTOUT); t.K = DM; t.N = DM; t.src_n0 = 32 * nb; t.dst_row0 = 32 * nb; t.k0 = 64 * kb; return t; }
    r -= I_OUT;
    { const int g = r / 128, q = r % 128, kb = q / 16, nb = q % 16; t.W = F.w_pool + (size_t)g * PGRP * PGRP; t.WT = (f16*)(F.ws + WS_WTPOOL) + (size_t)g * PGRP * PGRP; t.K = PGRP; t.N = PGRP; t.src_n0 = 32 * nb; t.dst_row0 = 32 * nb; t.k0 = 64 * kb; return t; }
}
__device__ __forceinline__ void p0_prologue(Frame& F) {
    LAS float* scr = (LAS float*)(F.lds + RING_OFF + F.wave * 16384);
    const int gw = F.vcu * NWAVES + F.wave, NGW = F.G * NWAVES;
    constexpr int NITEMS = 64 * (INWP / 32) + 64 * 128 + 4 * 8 * 16;
    {
        f32x4 va[8], vb[8]; int it = gw;
        TrItem ta, tb;
        if (it < NITEMS) { ta = p0_item(F, it); tr_load(ta, va, F.lane); }
        while (it < NITEMS) {
            const int itn = it + NGW;
            if (itn < NITEMS) { tb = p0_item(F, itn); tr_load(tb, vb, F.lane); }
            tr_finish(ta, va, scr, F.lane);
            if (itn >= NITEMS) break;
            const int itn2 = itn + NGW;
            if (itn2 < NITEMS) { ta = p0_item(F, itn2); tr_load(ta, va, F.lane); }
            tr_finish(tb, vb, scr, F.lane);
            it = itn2;
        }
    }
    f16* xn = (f16*)(F.ws + WS_XN);
    const GAS f32x4* gr = (const GAS f32x4*)F.ln_g + F.lane;
    f32x4 v[16], vn[16];
    int m = gw;
    if (m < NT) { const GAS f32x4* xr = (const GAS f32x4*)x_row(F, m) + F.lane;
#pragma unroll
        for (int j = 0; j < 16; ++j) v[j] = xr[64 * j]; }
    for (; m < NT; m += NGW) {
        const int mn = m + NGW;
        if (mn < NT) { const GAS f32x4* xr = (const GAS f32x4*)x_row(F, mn) + F.lane;
#pragma unroll
            for (int j = 0; j < 16; ++j) vn[j] = xr[64 * j]; }
        float s = 0.f;
#pragma unroll
        for (int j = 0; j < 16; ++j) s += (v[j].x * v[j].x + v[j].y * v[j].y) + (v[j].z * v[j].z + v[j].w * v[j].w);
        const float rstd = 1.0f / sqrtf(wave_sum(s) * (1.f / DM) + RMS_EPS);
        GAS u32x2* o8 = (GAS u32x2*)(xn + (size_t)m * DM) + F.lane;
#pragma unroll
        for (int j = 0; j < 16; ++j) { const f32x4 gg = gr[64 * j]; u32x2 w; w.x = pkh(v[j].x * rstd * gg.x, v[j].y * rstd * gg.y); w.y = pkh(v[j].z * rstd * gg.z, v[j].w * rstd * gg.w); o8[64 * j] = w; }
#pragma unroll
        for (int j = 0; j < 16; ++j) v[j] = vn[j];
    }
}

struct Epi1 {
    float* out; unsigned char* ws;
    __device__ __forceinline__ void operator()(const f32x4 (&acc)[2][2][4][2], const pg8::Unit& u, int wr, int wc, int fr, int fq) const {
        const int pn = u.pn; const int row0 = u.pm * 256 + wr * 64 + fr; const int cc0 = wc * 32 + 8 * fq;
#pragma unroll
        for (int ai = 0; ai < 2; ++ai)
#pragma unroll
            for (int m = 0; m < 4; ++m) {
                const int row = row0 + ai * 128 + m * 16;
#pragma unroll
                for (int bj = 0; bj < 2; ++bj) {
                    const int cc = cc0 + bj * 128; f32x4 v0 = acc[ai][bj][m][0], v1 = acc[ai][bj][m][1];
                    if (pn < 8) {
                        const float s = 0.12751743074602687f; u32x4 w; w.x = pkh(v0.x * s, v0.y * s); w.y = pkh(v0.z * s, v0.w * s); w.z = pkh(v1.x * s, v1.y * s); w.w = pkh(v1.z * s, v1.w * s);
                        *(GAS u32x4*)((f16*)(ws + WS_Q) + (size_t)row * ATTW + pn * 256 + cc) = w;
                    } else if (pn < 12) {
                        const bool isv = pn >= 10; const int col = (pn - (isv ? 10 : 8)) * 256 + cc;
                        float* o = out + (row < NPROMPT ? (isv ? OFF_VP : OFF_KP) + (size_t)row * KVW : (isv ? OFF_VS : OFF_KS) + (size_t)(row - NPROMPT) * KVW) + col;
                        *(GAS f32x4*)o = v0; *(GAS f32x4*)(o + 4) = v1;
                        u32x4 w; w.x = pkh(v0.x, v0.y); w.y = pkh(v0.z, v0.w); w.z = pkh(v1.x, v1.y); w.w = pkh(v1.z, v1.w);
                        *(GAS u32x4*)((f16*)(ws + (isv ? WS_VH : WS_KH)) + (size_t)row * KVW + col) = w;
                    } else if (pn < 20 || pn >= 45) {
                        const bool isb = pn >= 45; const int col = (pn - (isb ? 45 : 12)) * 256 + cc;
                        u32x4 w; w.x = pkh(silu_f(v0.x), silu_f(v0.y)); w.y = pkh(silu_f(v0.z), silu_f(v0.w)); w.z = pkh(silu_f(v1.x), silu_f(v1.y)); w.w = pkh(silu_f(v1.z), silu_f(v1.w));
                        *(GAS u32x4*)((f16*)(ws + (isb ? WS_GB : WS_GA)) + (size_t)row * 2048 + col) = w;
                    } else if (pn < 36) {
                        const float s = 0.08838834764831845f; u32x4 w; w.x = pkh(v0.x * s, v0.y * s); w.y = pkh(v0.z * s, v0.w * s); w.z = pkh(v1.x * s, v1.y * s); w.w = pkh(v1.z * s, v1.w * s);
                        *(GAS u32x4*)((f16*)(ws + WS_QI) + (size_t)row * 4096 + (pn - 20) * 256 + cc) = w;
                    } else if (pn == 36) {
                        if (cc < 32) { const float s = 0.17677669529663687f; float* o = (float*)(ws + WS_WI) + (size_t)row * 32 + cc; *(GAS f32x4*)o = v0 * s; *(GAS f32x4*)(o + 4) = v1 * s; }
                        else if (cc < 160) { const int col = cc - 32;
                            float* o = out + (row < NPROMPT ? OFF_IKP + (size_t)row * IDIM : OFF_IKS + (size_t)(row - NPROMPT) * IDIM) + col;
                            *(GAS f32x4*)o = v0; *(GAS f32x4*)(o + 4) = v1;
                            u32x4 w; w.x = pkh(v0.x, v0.y); w.y = pkh(v0.z, v0.w); w.z = pkh(v1.x, v1.y); w.w = pkh(v1.z, v1.w);
                            *(GAS u32x4*)((f16*)(ws + WS_KI) + (size_t)row * IDIM + col) = w; }
                    } else {
                        float* o = (float*)(ws + WS_U) + (size_t)row * PW + (pn - 37) * 256 + cc; *(GAS f32x4*)o = v0; *(GAS f32x4*)(o + 4) = v1;
                    }
                }
            }
    }
};
struct EpiPool {
    const float* pool_scale; unsigned char* ws;
    __device__ __forceinline__ void operator()(const f32x4 (&acc)[2][2][4][2], const pg8::Unit& u, int wr, int wc, int fr, int fq) const {
        const int row0 = u.pm * 256 + wr * 64 + fr, col0 = u.pn * 256 + wc * 32 + 8 * fq;
#pragma unroll
        for (int bj = 0; bj < 2; ++bj) {
            const int col = col0 + bj * 128; const f32x4 s0 = *(const GAS f32x4*)(pool_scale + col), s1 = *(const GAS f32x4*)(pool_scale + col + 4);
#pragma unroll
            for (int ai = 0; ai < 2; ++ai)
#pragma unroll
                for (int m = 0; m < 4; ++m) { const int row = row0 + ai * 128 + m * 16;
                    const f16x8 gb = *(const GAS f16x8*)((const f16*)(ws + WS_GB) + (size_t)row * PW + col);
                    const f32x4 v0 = acc[ai][bj][m][0] * s0, v1 = acc[ai][bj][m][1] * s1;
                    u32x4 w; w.x = pkh(v0.x * (float)gb[0], v0.y * (float)gb[1]); w.y = pkh(v0.z * (float)gb[2], v0.w * (float)gb[3]);
                    w.z = pkh(v1.x * (float)gb[4], v1.y * (float)gb[5]); w.w = pkh(v1.z * (float)gb[6], v1.w * (float)gb[7]);
                    *(GAS u32x4*)((f16*)(ws + WS_MIX) + (size_t)row * DM + ATTW + col) = w; }
        }
    }
};
struct Epi2 {
    const float* x_prompt; const float* x_sample; unsigned char* ws;
    __device__ __forceinline__ void operator()(const f32x4 (&acc)[2][2][4][2], const pg8::Unit& u, int wr, int wc, int fr, int fq) const {
        const int row0 = u.pm * 256 + wr * 64 + fr, col0 = u.pn * 256 + wc * 32 + 8 * fq;
#pragma unroll
        for (int ai = 0; ai < 2; ++ai)
#pragma unroll
            for (int m = 0; m < 4; ++m) { const int row = row0 + ai * 128 + m * 16;
                const float* xr = row < NPROMPT ? x_prompt + (size_t)row * DM : x_sample + (size_t)(row - NPROMPT) * DM;
                float* hr = (float*)(ws + WS_H) + (size_t)row * DM;
#pragma unroll
                for (int bj = 0; bj < 2; ++bj) { const int col = col0 + bj * 128;
                    const f32x4 a = *(const GAS f32x4*)(xr + col), b = *(const GAS f32x4*)(xr + col + 4);
                    *(GAS f32x4*)(hr + col) = a + acc[ai][bj][m][0]; *(GAS f32x4*)(hr + col + 4) = b + acc[ai][bj][m][1]; }
            }
    }
};


template <class EpiS>
__device__ __forceinline__ void skinny_unit(const f16* A, int lda, const f16* Bt, int ldb, int K, int n0, int wave, int lane, const EpiS& E) {
    const int fr = lane & 15, fq = lane >> 4;
    const f16* a0 = A + (size_t)(32 * wave + fr) * lda + 8 * fq; const f16* a1 = a0 + (size_t)16 * lda; const f16* bp = Bt + (size_t)(n0 + fr) * ldb + 8 * fq;
    f32x4 c0 = (f32x4){0.f, 0.f, 0.f, 0.f}, c1 = (f32x4){0.f, 0.f, 0.f, 0.f};
    for (int k = 0; k < K; k += 256) {
        f16x8 fa0[8], fa1[8], fb[8];
#pragma unroll
        for (int u = 0; u < 8; ++u) { fa0[u] = *(const GAS f16x8*)(a0 + k + 32 * u); fa1[u] = *(const GAS f16x8*)(a1 + k + 32 * u); fb[u] = *(const GAS f16x8*)(bp + k + 32 * u); }
#pragma unroll
        for (int u = 0; u < 8; ++u) { c0 = __builtin_amdgcn_mfma_f32_16x16x32_f16(fb[u], fa0[u], c0, 0, 0, 0); c1 = __builtin_amdgcn_mfma_f32_16x16x32_f16(fb[u], fa1[u], c1, 0, 0, 0); }
    }
    E(NPROMPT + 32 * wave + fr, n0 + 4 * fq, c0); E(NPROMPT + 32 * wave + 16 + fr, n0 + 4 * fq, c1);
}
struct EpiS2 { const float* x_sample; unsigned char* ws;
    __device__ __forceinline__ void operator()(int row, int col, f32x4 acc) const { const f32x4 xv = *(const GAS f32x4*)(x_sample + (size_t)(row - NPROMPT) * DM + col);
        *(GAS f32x4*)((float*)(ws + WS_H) + (size_t)row * DM + col) = xv + acc; } };
struct EpiSPool { const float* pool_scale; unsigned char* ws;
    __device__ __forceinline__ void operator()(int row, int col, f32x4 acc) const { const f32x4 sc = *(const GAS f32x4*)(pool_scale + col); const f16x4 gb = *(const GAS f16x4*)((const f16*)(ws + WS_GB) + (size_t)row * PW + col);
        const f32x4 v = acc * sc; u32x2 w; w.x = pkh(v.x * (float)gb[0], v.y * (float)gb[1]); w.y = pkh(v.z * (float)gb[2], v.w * (float)gb[3]);
        *(GAS u32x2*)((f16*)(ws + WS_MIX) + (size_t)row * DM + ATTW + col) = w; } };

constexpr int L_QROW = 0, L_WROW = 8192, L_PART = 8448, L_SC = 9216, L_SCAN = 9216 + 8256 * 4;
__device__ __forceinline__ unsigned fkey(float f) { const unsigned u = __builtin_bit_cast(unsigned, f); return (u & 0x80000000u) ? ~u : (u | 0x80000000u); }
__device__ __forceinline__ void p2_select_row(Frame& F, int r) {
    const int tid = F.tid, lane = F.lane, wave = F.wave;
    LAS unsigned char* L = F.lds;
    const bool samp = r >= NPROMPT;
    const int bd = samp ? (r - NPROMPT) / DS : 0, tt = samp ? (r - NPROMPT) % DS : (r % SEQ), bq = samp ? 0 : r / SEQ;
    const int nkeys = samp ? PAST + tt + 1 : tt + 1;
    int* selrow = (int*)(F.ws + WS_SEL) + (size_t)r * TOPK;
    if (nkeys <= TOPK) {
        for (int j = tid; j < TOPK; j += 512) selrow[j] = j < nkeys ? j : -1;
        return;
    }
    { const GAS u32x4* src = (const GAS u32x4*)((const f16*)(F.ws + WS_QI) + (size_t)r * 4096); ((LAS u32x4*)(L + L_QROW))[tid] = src[tid];
      if (tid < 32) ((LAS float*)(L + L_WROW))[tid] = ((const float*)(F.ws + WS_WI))[(size_t)r * 32 + tid]; }
    __syncthreads();
    LAS float* SC = (LAS float*)(L + L_SC);
    for (int s = tid; s < nkeys; s += 512) {
        f16x2 kk[64];
        if (!samp) { const GAS u32x4* kp = (const GAS u32x4*)((const f16*)(F.ws + WS_KI) + (size_t)(bq * SEQ + s) * IDIM);
#pragma unroll
            for (int i = 0; i < 16; ++i) { const u32x4 w = kp[i]; kk[4 * i] = as_h2(w.x); kk[4 * i + 1] = as_h2(w.y); kk[4 * i + 2] = as_h2(w.z); kk[4 * i + 3] = as_h2(w.w); }
        } else if (s >= PAST) { const GAS u32x4* kp = (const GAS u32x4*)((const f16*)(F.ws + WS_KI) + (size_t)(NPROMPT + bd * DS + (s - PAST)) * IDIM);
#pragma unroll
            for (int i = 0; i < 16; ++i) { const u32x4 w = kp[i]; kk[4 * i] = as_h2(w.x); kk[4 * i + 1] = as_h2(w.y); kk[4 * i + 2] = as_h2(w.z); kk[4 * i + 3] = as_h2(w.w); }
        } else { const int pg = F.page_table[bd * NPAGES + (s >> 7)]; const GAS f32x4* kp = (const GAS f32x4*)(F.cache_ik + ((size_t)pg * PAGE + (s & 127)) * IDIM);
#pragma unroll
            for (int i = 0; i < 32; ++i) { const f32x4 w = kp[i]; f16x2 a, b; a.x = (f16)w.x; a.y = (f16)w.y; b.x = (f16)w.z; b.y = (f16)w.w; kk[2 * i] = a; kk[2 * i + 1] = b; }
        }
        float score = 0.f;
        for (int h = 0; h < IH; ++h) {
            const LAS u32x4* qh = (const LAS u32x4*)(L + L_QROW + h * 256); float a = 0.f;
#pragma unroll
            for (int i = 0; i < 16; ++i) { const u32x4 w = qh[i];
                a = __builtin_amdgcn_fdot2(as_h2(w.x), kk[4 * i], a, false); a = __builtin_amdgcn_fdot2(as_h2(w.y), kk[4 * i + 1], a, false);
                a = __builtin_amdgcn_fdot2(as_h2(w.z), kk[4 * i + 2], a, false); a = __builtin_amdgcn_fdot2(as_h2(w.w), kk[4 * i + 3], a, false); }
            score += ((const LAS float*)(L + L_WROW))[h] * fmaxf(a, 0.f);
        }
        ((LAS unsigned*)SC)[s] = fkey(score);
    }
    __syncthreads();
    LAS unsigned* KEY = (LAS unsigned*)(L + L_SC); LAS unsigned* PART = (LAS unsigned*)(L + L_PART);
    unsigned prefix = 0u;
    for (int bit = 31; bit >= 0; --bit) {
        const unsigned cand = prefix | (1u << bit); unsigned c = 0;
        for (int s = tid; s < nkeys; s += 512) c += KEY[s] >= cand ? 1u : 0u;
#pragma unroll
        for (int o = 1; o < 64; o <<= 1) c += __shfl_xor(c, o);
        const int pb = (bit & 1) * 8;
        if (lane == 0) PART[pb + wave] = c;
        __syncthreads();
        unsigned tot = 0;
#pragma unroll
        for (int w = 0; w < 8; ++w) tot += PART[pb + w];
        if (tot >= (unsigned)TOPK) prefix = cand;
        if (tot == (unsigned)TOPK) break;
    }
    __syncthreads();
    const int PER = (nkeys + 511) / 512; const int s0 = tid * PER, s1 = (s0 + PER) < nkeys ? (s0 + PER) : nkeys;
    int c = 0; for (int s = s0; s < s1; ++s) c += KEY[s] >= prefix ? 1 : 0;
    int inc = c;
#pragma unroll
    for (int o = 1; o < 64; o <<= 1) { const int y = __shfl_up(inc, o); if (lane >= o) inc += y; }
    LAS int* SCAN = (LAS int*)(L + L_SCAN);
    if (lane == 63) SCAN[wave] = inc;
    __syncthreads();
    int base = 0;
#pragma unroll
    for (int w = 0; w < 8; ++w) base += (w < wave) ? SCAN[w] : 0;
    int pos = base + inc - c;
    for (int s = s0; s < s1; ++s) if (KEY[s] >= prefix) { if (pos < TOPK) selrow[pos] = s; ++pos; }
    __syncthreads();
}

__device__ __forceinline__ void wave_select_row(const float* Srow, int t, unsigned* selm_row, int* sel_row, int lane) {
    const float NINF = -__builtin_inff(), PINF = __builtin_inff();
    float sc[32];
#pragma unroll
    for (int i = 0; i < 32; ++i) { const int j = lane + 64 * i; sc[i] = NINF; if (64 * i <= t) { if (j <= t) sc[i] = Srow[j]; } }
    float thr = NINF;
    if (t + 1 > TOPK) {
        float mx = NINF, mn = PINF;
#pragma unroll
        for (int i = 0; i < 32; ++i) { mx = fmaxf(mx, sc[i]); mn = fminf(mn, (lane + 64 * i) <= t ? sc[i] : PINF); }
#pragma unroll
        for (int o = 1; o < 64; o <<= 1) { mx = fmaxf(mx, __shfl_xor(mx, o)); mn = fminf(mn, __shfl_xor(mn, o)); }
        float lo = mn, hi = mx;
        { int c = 0;
#pragma unroll
          for (int i = 0; i < 32; ++i) c += __popcll(__ballot(sc[i] >= hi));
          if (c >= TOPK) lo = hi; }
        thr = lo;
        for (int it = 0; it < 64; ++it) {
            const float mid = lo + 0.5f * (hi - lo);
            if (!(mid > lo && mid < hi)) break;
            int c = 0;
#pragma unroll
            for (int i = 0; i < 32; ++i) c += __popcll(__ballot(sc[i] >= mid));
            if (c == TOPK) { thr = mid; break; }
            if (c > TOPK) { lo = mid; thr = mid; } else hi = mid;
        }
    }
    unsigned wlo = 0u, whi = 0u; int base = 0;
#pragma unroll
    for (int i = 0; i < 32; ++i) { const int j = lane + 64 * i; const bool sel = (j <= t) && (sc[i] >= thr);
        const unsigned long long bm = __ballot(sel);
        if (lane == i) { wlo = (unsigned)bm; whi = (unsigned)(bm >> 32); }
        const int pos = base + (int)__builtin_amdgcn_mbcnt_hi((unsigned)(bm >> 32), __builtin_amdgcn_mbcnt_lo((unsigned)bm, 0u));
        if (sel && pos < TOPK) sel_row[pos] = j;
        base += __popcll(bm); }
    if (lane < 32) { u32x2 w; w.x = wlo; w.y = whi; *(GAS u32x2*)(selm_row + 2 * lane) = w; }
    for (int p = base + lane; p < TOPK; p += 64) sel_row[p] = -1;
}
constexpr int IX_ROWB = 272, IX_BUF = 128 * IX_ROWB;
__device__ __forceinline__ void p2_prompt_unit(Frame& F, int b, int g) {
    const int tid = F.tid, lane = F.lane, wave = F.wave, l31 = lane & 31, hh = lane >> 5; LAS unsigned char* L = F.lds;
    const int t0 = 16 * g, ra = b * SEQ + t0 + 2 * wave, rb = ra + 1;
    const f16* QI = (const f16*)(F.ws + WS_QI); const float* WI = (const float*)(F.ws + WS_WI); const f16* KI = (const f16*)(F.ws + WS_KI);
    float* S = (float*)(F.ws + WS_S);
    f16x8 Aa[8], Ab[8]; float wa[16], wb[16];
#pragma unroll
    for (int s = 0; s < 8; ++s) { Aa[s] = *(const GAS f16x8*)(QI + (size_t)ra * 4096 + l31 * IDIM + 16 * s + 8 * hh); Ab[s] = *(const GAS f16x8*)(QI + (size_t)rb * 4096 + l31 * IDIM + 16 * s + 8 * hh); }
#pragma unroll
    for (int i = 0; i < 16; ++i) { const int head = (i & 3) + 8 * (i >> 2) + 4 * hh; wa[i] = WI[(size_t)ra * 32 + head]; wb[i] = WI[(size_t)rb * 32 + head]; }
    const int nkeys = t0 + 16, nch = (nkeys + 127) >> 7;
    const GAS u32x4* kbase = (const GAS u32x4*)(KI + (size_t)b * SEQ * IDIM);
    u32x4 st[4];
#pragma unroll
    for (int k = 0; k < 4; ++k) st[k] = kbase[tid + 512 * k];
#pragma unroll
    for (int k = 0; k < 4; ++k) { const int idx = tid + 512 * k; *(LAS u32x4*)(L + (idx >> 4) * IX_ROWB + (idx & 15) * 16) = st[k]; }
    __syncthreads();
    for (int c = 0; c < nch; ++c) {
        const bool more = (c + 1) < nch;
        if (more) {
#pragma unroll
            for (int k = 0; k < 4; ++k) st[k] = kbase[(size_t)(c + 1) * 2048 + tid + 512 * k]; }
        LAS unsigned char* buf = L + (c & 1) * IX_BUF;
        for (int kt = 0; kt < 4; ++kt) {
            const int key0 = 128 * c + 32 * kt;
            if (key0 < nkeys) {
                f16x8 Bf[8];
#pragma unroll
                for (int s = 0; s < 8; ++s) Bf[s] = *(const LAS f16x8*)(buf + (32 * kt + l31) * IX_ROWB + (16 * s + 8 * hh) * 2);
                f32x16 ca, cb;
#pragma unroll
                for (int i = 0; i < 16; ++i) { ca[i] = 0.f; cb[i] = 0.f; }
#pragma unroll
                for (int s = 0; s < 8; ++s) { ca = __builtin_amdgcn_mfma_f32_32x32x16_f16(Aa[s], Bf[s], ca, 0, 0, 0); cb = __builtin_amdgcn_mfma_f32_32x32x16_f16(Ab[s], Bf[s], cb, 0, 0, 0); }
                float pa = 0.f, pb = 0.f;
#pragma unroll
                for (int i = 0; i < 16; ++i) { pa += wa[i] * fmaxf(ca[i], 0.f); pb += wb[i] * fmaxf(cb[i], 0.f); }
                pa += __shfl_xor(pa, 32); pb += __shfl_xor(pb, 32);
                S[(size_t)(hh ? rb : ra) * SEQ + key0 + l31] = hh ? pb : pa;
            }
        }
        if (more) {
#pragma unroll
            for (int k = 0; k < 4; ++k) { const int idx = tid + 512 * k; *(LAS u32x4*)(L + ((c + 1) & 1) * IX_BUF + (idx >> 4) * IX_ROWB + (idx & 15) * 16) = st[k]; } }
        __syncthreads();
    }
    VM_WAIT();
    unsigned* SELM = (unsigned*)(F.ws + WS_SELM); int* SEL = (int*)(F.ws + WS_SEL);
    wave_select_row(S + (size_t)ra * SEQ, t0 + 2 * wave, SELM + (size_t)ra * 64, SEL + (size_t)ra * TOPK, lane);
    wave_select_row(S + (size_t)rb * SEQ, t0 + 2 * wave + 1, SELM + (size_t)rb * 64, SEL + (size_t)rb * TOPK, lane);
}


__device__ __forceinline__ int perm16(int t) { const int q = (t >> 2) & 3; return (t & ~12) | ((q == 1 ? 2 : (q == 2 ? 1 : q)) << 2); }
__device__ __forceinline__ void p2_transpose_v(Frame& F) {
    const f16* VH = (const f16*)(F.ws + WS_VH); f16* VT = (f16*)(F.ws + WS_VT);
    const int gw = F.vcu * NWAVES + F.wave, NGW = F.G * NWAVES;
    for (int it = gw; it < 128 * 4 * 16; it += NGW) { const int c = it & 15, g = (it >> 4) & 3, tg = it >> 6; const int tok = tg * 64 + F.lane, b = tok >> 11, t = tok & 2047;
        const f16x8 v = *(const GAS f16x8*)(VH + (size_t)tok * KVW + g * HD + 8 * c);
        f16* dst = VT + ((size_t)((b * NKV + g) * HD + 8 * c)) * SEQ + perm16(t);
#pragma unroll
        for (int e = 0; e < 8; ++e) dst[(size_t)e * SEQ] = v[e]; }
}

constexpr int AT_KROW = 272, AT_KBUF = 64 * AT_KROW, AT_VROW = 144, AT_VBUF = 128 * AT_VROW;
constexpr int AT_K0 = 0, AT_V0 = 2 * AT_KBUF, AT_MASK = AT_V0 + 2 * AT_VBUF, AT_BT = AT_MASK + 64 * 65 * 4, AT_END = AT_BT + 128 * 4 * 4;
static_assert(AT_END <= RING_BYTES, "attention LDS");
__device__ __forceinline__ void p3_prompt_unit(Frame& F, int b, int g, int qb) {
    const int tid = F.tid, lane = F.lane, wave = F.wave, l31 = lane & 31, hh = lane >> 5; LAS unsigned char* L = F.lds;
    const int hq = wave & 3, qhalf = wave >> 2, head = 4 * g + hq;
    const int tq = 64 * qb + 32 * qhalf + l31, row = b * SEQ + tq;
    const f16* Q = (const f16*)(F.ws + WS_Q); const f16* KH = (const f16*)(F.ws + WS_KH); const f16* VT = (const f16*)(F.ws + WS_VT);
    { const unsigned* SELM = (const unsigned*)(F.ws + WS_SELM) + (size_t)(b * SEQ + 64 * qb) * 64; LAS unsigned* M = (LAS unsigned*)(L + AT_MASK);
      for (int i = tid; i < 64 * 64; i += 512) M[(i >> 6) * 65 + (i & 63)] = SELM[i];
      LAS float* BT = (LAS float*)(L + AT_BT); const int d = tid >> 2, h4 = tid & 3; int bk = d;
      if (d >= 16) { bk = 16 + (int)(__logf((float)d * (1.0f / 16.0f)) * (16.0f / 2.0794415416798357f)); bk = bk < 31 ? bk : 31; }
      BT[tid] = (F.rel_bias[bk * NH + 4 * g + h4] - F.rel_bias[31 * NH + 4 * g + h4]) * 1.4426950408889634f; }
    f16x8 Qf[8];
#pragma unroll
    for (int s = 0; s < 8; ++s) Qf[s] = *(const GAS f16x8*)(Q + (size_t)row * ATTW + head * HD + 16 * s + 8 * hh);
    f32x16 O[4];
#pragma unroll
    for (int dt = 0; dt < 4; ++dt)
#pragma unroll
        for (int i = 0; i < 16; ++i) O[dt][i] = 0.f;
    float m = -1e30f, lsum = 0.f;
    const int nkt = qb + 1;
    const GAS u32x4* ksrc = (const GAS u32x4*)(KH + (size_t)b * SEQ * KVW + g * HD);
    const GAS u32x4* vsrc = (const GAS u32x4*)(VT + (size_t)((b * NKV + g) * HD) * SEQ);
    u32x4 stK[2], stV[2];
#define AT_LOAD(kt) do { _Pragma("unroll") for (int k = 0; k < 2; ++k) { const int idx = tid + 512 * k; \
        stK[k] = ksrc[(size_t)(64 * (kt) + (idx >> 4)) * 64 + (idx & 15)]; stV[k] = vsrc[(size_t)(idx >> 3) * 256 + 8 * (kt) + (idx & 7)]; } } while (0)
#define AT_STORE(buf) do { _Pragma("unroll") for (int k = 0; k < 2; ++k) { const int idx = tid + 512 * k; \
        *(LAS u32x4*)(L + AT_K0 + (buf) * AT_KBUF + (idx >> 4) * AT_KROW + (idx & 15) * 16) = stK[k]; \
        *(LAS u32x4*)(L + AT_V0 + (buf) * AT_VBUF + (idx >> 3) * AT_VROW + (idx & 7) * 16) = stV[k]; } } while (0)
    AT_LOAD(0); AT_STORE(0);
    __syncthreads();
    for (int kt = 0; kt < nkt; ++kt) {
        const bool more = (kt + 1) < nkt;
        if (more) AT_LOAD(kt + 1);
        const LAS unsigned char* Kb = L + AT_K0 + (kt & 1) * AT_KBUF; const LAS unsigned char* Vb = L + AT_V0 + (kt & 1) * AT_VBUF;
        const int kbase = l31 * AT_KROW + 16 * hh, vbase = l31 * AT_VROW + 16 * hh;
#pragma nounroll
        for (int ks = 0; ks < 2; ++ks) {
            const LAS unsigned char* Kp = Kb + kbase + ks * (32 * AT_KROW); const LAS unsigned char* Vp = Vb + vbase + ks * 64;
            f32x16 sa;
#pragma unroll
            for (int i = 0; i < 16; ++i) sa[i] = 0.f;
#pragma unroll
            for (int s = 0; s < 8; ++s) { const f16x8 kf = *(const LAS f16x8*)(Kp + 32 * s); sa = __builtin_amdgcn_mfma_f32_32x32x16_f16(kf, Qf[s], sa, 0, 0, 0); }
            const int key0 = 64 * kt + 32 * ks;
            if ((64 * qb + 32 * qhalf) - (key0 + 31) < 113) {
                const LAS float* BT = (const LAS float*)(L + AT_BT);
#pragma unroll
                for (int i = 0; i < 16; ++i) { int dist = tq - (key0 + (i & 3) + 8 * (i >> 2) + 4 * hh); dist = dist < 0 ? 0 : (dist > 127 ? 127 : dist); sa[i] += BT[dist * 4 + hq]; }
            }
            float mx = sa[0];
#pragma unroll
            for (int i = 1; i < 16; ++i) mx = fmaxf(mx, sa[i]);
            mx = fmaxf(mx, __shfl_xor(mx, 32));
            if (!__all(mx <= m + 8.0f)) {
                const float mn = fmaxf(m, mx), alpha = __builtin_amdgcn_exp2f(m - mn); m = mn; lsum *= alpha;
#pragma unroll
                for (int dt = 0; dt < 4; ++dt)
#pragma unroll
                    for (int i = 0; i < 16; ++i) O[dt][i] *= alpha;
            }
            const int mw = (int)(((const LAS unsigned*)(L + AT_MASK))[(32 * qhalf + l31) * 65 + 2 * kt + ks] >> (4 * hh));
            f16x8 Pf[2];
#pragma unroll
            for (int i = 0; i < 16; ++i) { float p = __builtin_amdgcn_exp2f(sa[i] - m);
                const int msk = __builtin_amdgcn_sbfe(mw, (i & 3) + 8 * (i >> 2), 1);
                p = __builtin_bit_cast(float, __builtin_bit_cast(int, p) & msk); lsum += p; Pf[i >> 3][i & 7] = (f16)p; }
#pragma unroll
            for (int sp = 0; sp < 2; ++sp)
#pragma unroll
                for (int dt = 0; dt < 4; ++dt) { const f16x8 vf = *(const LAS f16x8*)(Vp + dt * (32 * AT_VROW) + 32 * sp);
                    O[dt] = __builtin_amdgcn_mfma_f32_32x32x16_f16(vf, Pf[sp], O[dt], 0, 0, 0); }
        }
        if (more) AT_STORE((kt + 1) & 1);
        __syncthreads();
    }
#undef AT_LOAD
#undef AT_STORE
    lsum += __shfl_xor(lsum, 32);
    const float inv = 1.0f / lsum;
    const f16* GA = (const f16*)(F.ws + WS_GA) + (size_t)row * ATTW + head * HD; f16* MX = (f16*)(F.ws + WS_MIX) + (size_t)row * DM + head * HD;
#pragma unroll
    for (int dt = 0; dt < 4; ++dt)
#pragma unroll
        for (int q4 = 0; q4 < 4; ++q4) { const int d = 32 * dt + 8 * q4 + 4 * hh; const f16x4 ga = *(const GAS f16x4*)(GA + d);
            u32x2 w; w.x = pkh(O[dt][4 * q4] * inv * (float)ga[0], O[dt][4 * q4 + 1] * inv * (float)ga[1]); w.y = pkh(O[dt][4 * q4 + 2] * inv * (float)ga[2], O[dt][4 * q4 + 3] * inv * (float)ga[3]);
            *(GAS u32x2*)(MX + d) = w; }
}


constexpr int S2_LD = 8256;
__device__ __forceinline__ void p2_sample_unit(Frame& F, int bd, int e) {
    const int tid = F.tid, lane = F.lane, wave = F.wave, l31 = lane & 31, hh = lane >> 5; LAS unsigned char* L = F.lds;
    const int row = NPROMPT + bd * DS + wave;
    const f16* QI = (const f16*)(F.ws + WS_QI); const float* WI = (const float*)(F.ws + WS_WI);
    float* S2row = (float*)(F.ws + WS_S2) + (size_t)(bd * DS + wave) * S2_LD;
    f16x8 Aq[8]; float wq[16];
#pragma unroll
    for (int s = 0; s < 8; ++s) Aq[s] = *(const GAS f16x8*)(QI + (size_t)row * 4096 + l31 * IDIM + 16 * s + 8 * hh);
#pragma unroll
    for (int i = 0; i < 16; ++i) wq[i] = WI[(size_t)row * 32 + (i & 3) + 8 * (i >> 2) + 4 * hh];
    f32x4 st[8];
#define SX_LOAD(pi) do { const int pg_ = F.page_table[bd * NPAGES + 8 * e + (pi)]; const GAS f32x4* src_ = (const GAS f32x4*)(F.cache_ik + (size_t)pg_ * PAGE * IDIM); \
        _Pragma("unroll") for (int k = 0; k < 8; ++k) st[k] = src_[tid + 512 * k]; } while (0)
#define SX_STORE(buf) do { _Pragma("unroll") for (int k = 0; k < 8; ++k) { const int idx = tid + 512 * k; u32x2 w_; w_.x = pkh(st[k].x, st[k].y); w_.y = pkh(st[k].z, st[k].w); \
        *(LAS u32x2*)(L + (buf) * IX_BUF + (idx >> 5) * IX_ROWB + (idx & 31) * 8) = w_; } } while (0)
#define SX_TILE(bufp, kt, keybase) do { f16x8 Bf[8]; \
        _Pragma("unroll") for (int s = 0; s < 8; ++s) Bf[s] = *(const LAS f16x8*)((bufp) + (32 * (kt) + l31) * IX_ROWB + (16 * s + 8 * hh) * 2); \
        f32x16 ca; _Pragma("unroll") for (int i = 0; i < 16; ++i) ca[i] = 0.f; \
        _Pragma("unroll") for (int s = 0; s < 8; ++s) ca = __builtin_amdgcn_mfma_f32_32x32x16_f16(Aq[s], Bf[s], ca, 0, 0, 0); \
        float pa = 0.f; _Pragma("unroll") for (int i = 0; i < 16; ++i) pa += wq[i] * fmaxf(ca[i], 0.f); \
        pa += __shfl_xor(pa, 32); if (hh == 0) S2row[(keybase) + 32 * (kt) + l31] = pa; } while (0)
    SX_LOAD(0); SX_STORE(0);
    __syncthreads();
    for (int pi = 0; pi < 8; ++pi) {
        const bool more = (pi + 1) < 8;
        if (more) SX_LOAD(pi + 1);
        const LAS unsigned char* buf = L + (pi & 1) * IX_BUF;
        for (int kt = 0; kt < 4; ++kt) SX_TILE(buf, kt, (8 * e + pi) * PAGE);
        if (more) SX_STORE((pi + 1) & 1);
        __syncthreads();
    }
    if (e == 7) {
        if (tid < DS * 16) *(LAS u32x4*)(L + (tid >> 4) * IX_ROWB + (tid & 15) * 16) = *(const GAS u32x4*)((const f16*)(F.ws + WS_KI) + (size_t)(NPROMPT + bd * DS) * IDIM + tid * 8);
        __syncthreads();
        SX_TILE(L, 0, PAST);
        __syncthreads();
    }
#undef SX_LOAD
#undef SX_STORE
#undef SX_TILE
}

__device__ __forceinline__ void p2_pool_diff(Frame& F) {
    const float* U = (const float*)(F.ws + WS_U); f16* D = (f16*)(F.ws + WS_D);
    for (int it = blockIdx.x * 512 + F.tid; it < NB * 64 * (PW / 4); it += F.G * 512) {
        const int c4 = (it & 511) * 4, run = (it >> 9) & 63, b = it >> 15; const int g = c4 / PGRP, win = 2 << g; const int t0 = run * 32;
        const float* ub = U + (size_t)b * SEQ * PW + c4; f16* db = D + (size_t)b * SEQ * PW + c4;
        f32x4 sum = (f32x4){0.f, 0.f, 0.f, 0.f};
        for (int j = (t0 - win) > 0 ? (t0 - win) : 0; j < t0; ++j) sum += *(const GAS f32x4*)(ub + (size_t)j * PW);
#pragma unroll 4
        for (int t = t0; t < t0 + 32; ++t) {
            const f32x4 x = *(const GAS f32x4*)(ub + (size_t)t * PW); sum += x;
            if (t - win >= 0) sum -= *(const GAS f32x4*)(ub + (size_t)(t - win) * PW);
            const float inv = 1.0f / (float)((t + 1) < win ? (t + 1) : win);
            const f32x4 d = sum * inv - x; u32x2 w; w.x = pkh(d.x, d.y); w.y = pkh(d.z, d.w);
            *(GAS u32x2*)(db + (size_t)t * PW) = w;
        }
    }
    for (int it = blockIdx.x * 512 + F.tid; it < NSAMP * (PW / 4); it += F.G * 512) {
        const int r = NPROMPT + it / (PW / 4), c4 = (it % (PW / 4)) * 4; const int g = c4 / PGRP, win = 2 << g;
        const int q = r - NPROMPT, bd = q / DS, t = q % DS; const float inv = 1.0f / (float)win;
        f32x4 sum = (f32x4){0.f, 0.f, 0.f, 0.f}; const f32x4 self = *(const GAS f32x4*)(U + (size_t)r * PW + c4);
        for (int j = 0; j < win; ++j) { const int tj = t - j;
            sum += tj >= 0 ? *(const GAS f32x4*)(U + (size_t)(r - j) * PW + c4) : *(const GAS f32x4*)(F.state_pool + ((size_t)bd * PSTATE + (PSTATE + tj)) * PW + c4); }
        const f32x4 d = sum * inv - self; u32x2 w; w.x = pkh(d.x, d.y); w.y = pkh(d.z, d.w);
        *(GAS u32x2*)(D + (size_t)r * PW + c4) = w;
    }
    const size_t np = (size_t)NB * PSTATE * (PW / 4), nsm = (size_t)DB * PSTATE * (PW / 4);
    for (size_t i = (size_t)blockIdx.x * 512 + F.tid; i < np + nsm; i += (size_t)F.G * 512) {
        if (i < np) { const int c4 = (int)(i % (PW / 4)) * 4, q = (int)(i / (PW / 4)), b = q / PSTATE, k = q % PSTATE;
            *(GAS f32x4*)(F.out + OFF_PSP + (size_t)q * PW + c4) = *(const GAS f32x4*)(U + (size_t)(b * SEQ + SEQ - PSTATE + k) * PW + c4);
        } else { const size_t j = i - np; const int c4 = (int)(j % (PW / 4)) * 4, q = (int)(j / (PW / 4)), bd = q / PSTATE, k = q % PSTATE;
            const f32x4 v = k < 7 ? *(const GAS f32x4*)(F.state_pool + ((size_t)bd * PSTATE + 8 + k) * PW + c4) : *(const GAS f32x4*)(U + (size_t)(NPROMPT + bd * DS + (k - 7)) * PW + c4);
            *(GAS f32x4*)(F.out + OFF_PSS + (size_t)q * PW + c4) = v; }
    }
}

constexpr int A_SEL = 0, A_BUCK = 1024, A_LG = 2048, A_PART = 18432;
__device__ __forceinline__ const float* kv_row_ptr(const Frame& F, bool samp, int bq, int bd, int pos, bool isv) {
    if (!samp) return F.out + (isv ? OFF_VP : OFF_KP) + (size_t)(bq * SEQ + pos) * KVW;
    if (pos >= PAST) return F.out + (isv ? OFF_VS : OFF_KS) + (size_t)(bd * DS + pos - PAST) * KVW;
    const int pg = F.page_table[bd * NPAGES + (pos >> 7)];
    return (isv ? F.cache_v : F.cache_k) + ((size_t)pg * PAGE + (pos & 127)) * KVW;
}

__device__ __forceinline__ void p3_sample_select(Frame& F, int r, LAS int* SELL, LAS unsigned* PARTS) {
    const int tid = F.tid, lane = F.lane, wave = F.wave;
    const int q = r - NPROMPT, t = q % DS, nkeys = PAST + t + 1;
    const float* S2row = (const float*)(F.ws + WS_S2) + (size_t)q * S2_LD;
    const float NINF = -__builtin_inff(), PINF = __builtin_inff();
    float v[17]; float mx = NINF, mn = PINF;
#pragma unroll
    for (int i = 0; i < 17; ++i) { const int j = tid * 17 + i; v[i] = j < nkeys ? S2row[j] : NINF; mx = fmaxf(mx, v[i]); mn = fminf(mn, j < nkeys ? v[i] : PINF); }
#pragma unroll
    for (int o = 1; o < 64; o <<= 1) { mx = fmaxf(mx, __shfl_xor(mx, o)); mn = fminf(mn, __shfl_xor(mn, o)); }
    LAS float* PF = (LAS float*)PARTS;
    if (lane == 0) { PF[32 + wave] = mx; PF[40 + wave] = mn; }
    __syncthreads();
#pragma unroll
    for (int w = 0; w < 8; ++w) { mx = fmaxf(mx, PF[32 + w]); mn = fminf(mn, PF[40 + w]); }
    float lo = mn, hi = mx, thr = mn;
    for (int it = 0; it < 64; ++it) {
        const float mid = lo + 0.5f * (hi - lo);
        if (!(mid > lo && mid < hi)) break;
        int c = 0;
#pragma unroll
        for (int i = 0; i < 17; ++i) c += __popcll(__ballot(v[i] >= mid));
        const int pb = (it & 1) * 8;
        if (lane == 0) PARTS[pb + wave] = (unsigned)c;
        __syncthreads();
        int tot = 0;
#pragma unroll
        for (int w = 0; w < 8; ++w) tot += (int)PARTS[pb + w];
        if (tot == TOPK) { thr = mid; break; }
        if (tot > TOPK) { lo = mid; thr = mid; } else hi = mid;
    }
    __syncthreads();
    int c = 0;
#pragma unroll
    for (int i = 0; i < 17; ++i) c += (v[i] >= thr && (tid * 17 + i) < nkeys) ? 1 : 0;
    int inc = c;
#pragma unroll
    for (int o = 1; o < 64; o <<= 1) { const int y = __shfl_up(inc, o); if (lane >= o) inc += y; }
    if (lane == 63) PARTS[16 + wave] = (unsigned)inc;
    __syncthreads();
    int pos = inc - c;
#pragma unroll
    for (int w = 0; w < 8; ++w) pos += (w < wave) ? (int)PARTS[16 + w] : 0;
#pragma unroll
    for (int i = 0; i < 17; ++i) if (v[i] >= thr && (tid * 17 + i) < nkeys) { if (pos < TOPK) SELL[pos] = tid * 17 + i; ++pos; }
    __syncthreads();
}
__device__ __forceinline__ void p3_attend_row(Frame& F, int r) {
    const int tid = F.tid, lane = F.lane, wave = F.wave; LAS unsigned char* L = F.lds;
    const bool samp = r >= NPROMPT;
    const int bd = samp ? (r - NPROMPT) / DS : 0, tt = samp ? (r - NPROMPT) % DS : (r % SEQ), bq = samp ? 0 : r / SEQ;
    const int qpos = samp ? PAST + tt : tt;
    LAS int* SELL = (LAS int*)(L + A_SEL); LAS int* BUCK = (LAS int*)(L + A_BUCK); LAS float* LG = (LAS float*)(L + A_LG); LAS float* PARTO = (LAS float*)(L + A_PART);
    if (samp) p3_sample_select(F, r, SELL, (LAS unsigned*)(L + A_LG));
    else if (tid < TOPK) SELL[tid] = ((const int*)(F.ws + WS_SEL))[(size_t)r * TOPK + tid];
    if (tid >= 256 && tid < 384) { const int d = tid - 256; int bk = d;
        if (d >= 16) { bk = 16 + (int)(__logf((float)d * (1.0f / 16.0f)) * (16.0f / 2.0794415416798357f)); bk = bk < 31 ? bk : 31; }
        BUCK[d] = bk; }
    const int g = lane >> 4, dl = (lane & 15) * 8;
    float q[4][8];
#pragma unroll
    for (int hh = 0; hh < 4; ++hh) { const f16x8 v = *(const GAS f16x8*)((const f16*)(F.ws + WS_Q) + (size_t)r * ATTW + (4 * g + hh) * HD + dl);
#pragma unroll
        for (int e = 0; e < 8; ++e) q[hh][e] = (float)v[e]; }
    __syncthreads();
    for (int i = 0; i < 32; ++i) {
        const int j = wave + 8 * i; const int pos = SELL[j];
        float part[4] = {0.f, 0.f, 0.f, 0.f};
        if (pos >= 0) {
            const float* kp = kv_row_ptr(F, samp, bq, bd, pos, false) + 8 * lane;
            const f32x4 k0 = *(const GAS f32x4*)kp, k1 = *(const GAS f32x4*)(kp + 4);
#pragma unroll
            for (int hh = 0; hh < 4; ++hh) part[hh] = (q[hh][0] * k0.x + q[hh][1] * k0.y) + (q[hh][2] * k0.z + q[hh][3] * k0.w) + (q[hh][4] * k1.x + q[hh][5] * k1.y) + (q[hh][6] * k1.z + q[hh][7] * k1.w);
#pragma unroll
            for (int hh = 0; hh < 4; ++hh) { part[hh] += __shfl_xor(part[hh], 1); part[hh] += __shfl_xor(part[hh], 2); part[hh] += __shfl_xor(part[hh], 4); part[hh] += __shfl_xor(part[hh], 8); }
        }
        if ((lane & 15) < 4) { const int hh = lane & 3, head = 4 * g + hh; float lg = -1e30f;
            if (pos >= 0) { const int d = qpos - pos; const int bk = d < 128 ? BUCK[d < 0 ? 0 : d] : 31;
                const float pv = hh == 0 ? part[0] : (hh == 1 ? part[1] : (hh == 2 ? part[2] : part[3]));
                lg = pv + F.rel_bias[bk * NH + head] * 1.4426950408889634f; }
            LG[head * TOPK + j] = lg; }
    }
    __syncthreads();
#pragma unroll
    for (int hq = 0; hq < 2; ++hq) { const int head = 2 * wave + hq; float v[4]; float mx = -3.0e38f;
#pragma unroll
        for (int i = 0; i < 4; ++i) { v[i] = LG[head * TOPK + lane + 64 * i]; mx = fmaxf(mx, v[i]); }
        mx = wave_max(mx); float s = 0.f;
#pragma unroll
        for (int i = 0; i < 4; ++i) { v[i] = __builtin_amdgcn_exp2f(v[i] - mx); s += v[i]; }
        s = wave_sum(s); const float inv = 1.0f / s;
#pragma unroll
        for (int i = 0; i < 4; ++i) LG[head * TOPK + lane + 64 * i] = v[i] * inv; }
    __syncthreads();
    float acc[4][8];
#pragma unroll
    for (int hh = 0; hh < 4; ++hh)
#pragma unroll
        for (int e = 0; e < 8; ++e) acc[hh][e] = 0.f;
    for (int i = 0; i < 32; ++i) {
        const int j = wave + 8 * i; const int pos = SELL[j];
        if (pos >= 0) {
            const float* vp = kv_row_ptr(F, samp, bq, bd, pos, true) + 8 * lane;
            const f32x4 v0 = *(const GAS f32x4*)vp, v1 = *(const GAS f32x4*)(vp + 4);
#pragma unroll
            for (int hh = 0; hh < 4; ++hh) { const float p = LG[(4 * g + hh) * TOPK + j];
                acc[hh][0] += p * v0.x; acc[hh][1] += p * v0.y; acc[hh][2] += p * v0.z; acc[hh][3] += p * v0.w;
                acc[hh][4] += p * v1.x; acc[hh][5] += p * v1.y; acc[hh][6] += p * v1.z; acc[hh][7] += p * v1.w; }
        }
    }
#pragma unroll
    for (int hh = 0; hh < 4; ++hh) { LAS f32x4* o = (LAS f32x4*)(PARTO + wave * 2048 + (4 * g + hh) * HD + dl);
        o[0] = (f32x4){acc[hh][0], acc[hh][1], acc[hh][2], acc[hh][3]}; o[1] = (f32x4){acc[hh][4], acc[hh][5], acc[hh][6], acc[hh][7]}; }
    __syncthreads();
    { f32x4 s = (f32x4){0.f, 0.f, 0.f, 0.f};
#pragma unroll
      for (int w = 0; w < 8; ++w) s += *(const LAS f32x4*)(PARTO + w * 2048 + tid * 4);
      const f16x4 ga = *(const GAS f16x4*)((const f16*)(F.ws + WS_GA) + (size_t)r * ATTW + tid * 4);
      u32x2 w; w.x = pkh(s.x * (float)ga[0], s.y * (float)ga[1]); w.y = pkh(s.z * (float)ga[2], s.w * (float)ga[3]);
      *(GAS u32x2*)((f16*)(F.ws + WS_MIX) + (size_t)r * DM + tid * 4) = w; }
    __syncthreads();
}

struct Args { const void* in[14]; float* out; unsigned char* ws; int ph_lo, ph_hi, li, pad; };
constexpr int PER_PHASE = 10;
__global__ void __launch_bounds__(NWAVES * 64, 2) mk_fwd(Args args) {
    extern __shared__ __attribute__((aligned(16))) unsigned char lds[];
    Frame F;
    F.lds = (LAS unsigned char*)lds;
    F.tid = threadIdx.x; F.lane = F.tid & 63; F.wave = __builtin_amdgcn_readfirstlane(F.tid >> 6);
    F.G = gridDim.x; { const int bx = blockIdx.x; F.vcu = (F.G % 8 == 0) ? (bx % 8) * (F.G / 8) + bx / 8 : bx; }
    F.x_prompt = (const float*)args.in[0]; F.x_sample = (const float*)args.in[1]; F.cache_k = (const float*)args.in[2]; F.cache_v = (const float*)args.in[3];
    F.cache_ik = (const float*)args.in[4]; F.state_pool = (const float*)args.in[5]; F.page_table = (const int*)args.in[6]; F.rel_bias = (const float*)args.in[7];
    F.ln_g = (const float*)args.in[8]; F.w_in = (const float*)args.in[9]; F.w_pool = (const float*)args.in[10]; F.pool_scale = (const float*)args.in[11];
    F.w_out = (const float*)args.in[12]; F.final_g = (const float*)args.in[13];
    F.out = args.out; F.ws = args.ws;
    volatile LAS unsigned* MISC = (volatile LAS unsigned*)(F.lds + MISC_OFF);
    for (int u = F.tid; u < (LDS_BYTES - LDSCTL_OFF) / 4; u += NWAVES * 64) ((LAS unsigned*)(F.lds + LDSCTL_OFF))[u] = 0u;
    __syncthreads();
    unsigned* ctl = (unsigned*)(F.ws + WS_CTL);
    XcdBarrier bar; bar.bar = ctl + CW_BAR + args.li * XCD_BAR_WORDS; bar.x = 0; bar.st = nullptr;
    if (MK_N_LAUNCHES != PER_PHASE) bar = xcd_barrier_post(ctl + CW_BAR + args.li * XCD_BAR_WORDS, MISC + 8);
    const int lo = args.ph_lo, hi = args.ph_hi;
#define IN(k) (lo <= (k) && (k) < hi)
#define BOTH(k) (IN(k) && IN((k) + 1))
#define GRID_BAR() do { if (MK_N_LAUNCHES != PER_PHASE) xcd_barrier(bar); } while (0)

    if (IN(0)) { p0_prologue(F); if (BOTH(0)) GRID_BAR(); }

    if (IN(1)) {
        pg8::Gemm g{(const f16*)(F.ws + WS_XN), (const f16*)(F.ws + WS_WTIN), NT, INWP, DM, DM, DM, 0, 0};
        pg8::StaticOrder S; S.init(NT, INWP, F.G, (int)blockIdx.x);
        Epi1 E{F.out, F.ws};
        pg8::gemm_phase<Epi1>(F.lds + RING_OFF, g, S, E);
        if (BOTH(1)) GRID_BAR();
    }
    if (IN(2)) { for (int c = blockIdx.x; c < 256; c += F.G) { const int b = c >> 6, j = c & 63; p2_prompt_unit(F, b, 127 - j); p2_prompt_unit(F, b, j); } }
    if (IN(3)) { for (int c = blockIdx.x; c < 256; c += F.G) p2_sample_unit(F, c >> 3, c & 7); }
    if (IN(4)) { p2_pool_diff(F); p2_transpose_v(F); if (BOTH(4)) GRID_BAR(); }
    if (IN(5)) { for (int c = blockIdx.x; c < 256; c += F.G) { const int bg = c >> 4, j = c & 15; p3_prompt_unit(F, bg >> 2, bg & 3, 31 - j); p3_prompt_unit(F, bg >> 2, bg & 3, j); } }
    if (IN(6)) { for (int r = NPROMPT + blockIdx.x; r < NT; r += F.G) p3_attend_row(F, r); }
    if (IN(7)) {
        pg8::Gemm g{(const f16*)(F.ws + WS_D), (const f16*)(F.ws + WS_WTPOOL), NPROMPT, PW, PGRP, PW, PGRP, 1, PGRP};
        pg8::StaticOrder S; S.init(NPROMPT, PW, F.G, (int)blockIdx.x);
        EpiPool E{F.pool_scale, F.ws};
        pg8::gemm_phase<EpiPool>(F.lds + RING_OFF, g, S, E);
        { EpiSPool ES{F.pool_scale, F.ws};
          for (int u = blockIdx.x; u < PW / 16; u += F.G) { const int n0 = 16 * u, grp = n0 / PGRP;
            skinny_unit((const f16*)(F.ws + WS_D) + (size_t)NPROMPT * PW + grp * PGRP, PW, (const f16*)(F.ws + WS_WTPOOL), PGRP, PGRP, n0, F.wave, F.lane, ES); } }
        if (BOTH(7)) GRID_BAR();
    }
    if (IN(8)) {
        { EpiS2 ES{F.x_sample, F.ws};
          for (int u = blockIdx.x; u < DM / 16; u += F.G) skinny_unit((const f16*)(F.ws + WS_MIX) + (size_t)NPROMPT * DM, DM, (const f16*)(F.ws + WS_WTOUT), DM, DM, 16 * u, F.wave, F.lane, ES); }
        pg8::Gemm g{(const f16*)(F.ws + WS_MIX), (const f16*)(F.ws + WS_WTOUT), NPROMPT, DM, DM, DM, DM, 0, 0};
        pg8::StaticOrder S; S.init(NPROMPT, DM, F.G, (int)blockIdx.x);
        Epi2 E{F.x_prompt, F.x_sample, F.ws};
        pg8::gemm_phase<Epi2>(F.lds + RING_OFF, g, S, E);
        if (BOTH(8)) GRID_BAR();
    }
    if (IN(9)) {
        const int gw = F.vcu * NWAVES + F.wave, NGW = F.G * NWAVES;
        for (int m = gw; m < NT; m += NGW) {
            const GAS f32x4* hr = (const GAS f32x4*)((const float*)(F.ws + WS_H) + (size_t)m * DM) + F.lane;
            f32x4 v[16]; float s = 0.f;
#pragma unroll
            for (int j = 0; j < 16; ++j) { v[j] = hr[64 * j]; s += (v[j].x * v[j].x + v[j].y * v[j].y) + (v[j].z * v[j].z + v[j].w * v[j].w); }
            const float rstd = 1.0f / sqrtf(wave_sum(s) * (1.f / DM) + RMS_EPS);
            GAS f32x4* o = (GAS f32x4*)(F.out + (m < NPROMPT ? OFF_YP + (size_t)m * DM : OFF_YS + (size_t)(m - NPROMPT) * DM)) + F.lane;
            const GAS f32x4* gr = (const GAS f32x4*)F.final_g + F.lane;
#pragma unroll
            for (int j = 0; j < 16; ++j) o[64 * j] = v[j] * rstd * gr[64 * j];
        }
    }
#undef IN
#undef BOTH
#undef GRID_BAR
}

extern "C" void kernel_launch(void* const* d_in, const int* in_sizes, int n_in, void* d_out, int out_size, void* d_ws, size_t ws_size, hipStream_t stream) {
    static int grid = 0;
    if (grid == 0) {
        if (n_in != 14 || out_size != (int)OUT_TOTAL || ws_size < WS_END) { fprintf(stderr, "kernel_launch: unexpected shapes (n_in %d, out %d, ws %zu)\n", n_in, out_size, ws_size); grid = -1; return; }
        int dev = 0, cus = 0, per_cu = 0;
        if (hipGetDevice(&dev) != hipSuccess || hipDeviceGetAttribute(&cus, hipDeviceAttributeMultiprocessorCount, dev) != hipSuccess) { grid = -1; return; }
        if (hipFuncSetAttribute((const void*)mk_fwd, hipFuncAttributeMaxDynamicSharedMemorySize, LDS_BYTES) != hipSuccess) { fprintf(stderr, "kernel_launch: hipFuncSetAttribute failed\n"); grid = -1; return; }
        if (hipOccupancyMaxActiveBlocksPerMultiprocessor(&per_cu, (const void*)mk_fwd, NWAVES * 64, LDS_BYTES) != hipSuccess || per_cu < 1)
            fprintf(stderr, "kernel_launch: note: occupancy query reports %d workgroups per CU\n", per_cu);
        (void)hipGetLastError();
        grid = cus;
    }
    if (grid < 0) return;
    if (hipMemsetAsync((char*)d_ws + WS_CTL, 0, CTL_ZERO_BYTES, stream) != hipSuccess) { fprintf(stderr, "kernel_launch: memset failed\n"); return; }
    Args a{};
    for (int i = 0; i < 14; ++i) a.in[i] = d_in[i];
    a.out = (float*)d_out; a.ws = (unsigned char*)d_ws;
    const int nl = (DUP_PHASE >= 0) ? 2 : MK_N_LAUNCHES;
    for (int li = 0; li < nl; ++li) {
        a.ph_lo = (nl == PER_PHASE) ? li : 0; a.ph_hi = (nl == PER_PHASE) ? li + 1 : PER_PHASE; a.li = li;
        if (DUP_PHASE >= 0) { a.ph_lo = li == 0 ? 0 : DUP_PHASE; a.ph_hi = li == 0 ? DUP_PHASE + 1 : PER_PHASE; }
        hipLaunchKernelGGL(mk_fwd, dim3(grid), dim3(NWAVES * 64), LDS_BYTES, stream, a);
        const hipError_t le = hipPeekAtLastError();
        if (le != hipSuccess) { fprintf(stderr, "kernel_launch: launch %d failed: %s\n", li, hipGetErrorName(le)); break; }
    }
}
```
